# Optimizing an MI355X kernel written in HIP

```python
import math
import jax, jax.numpy as jnp
from jax import lax
import numpy as np

D_MODEL = 1024
BATCH = 8
SEQ = 8192
DEPTH = 1

CHUNK = 64
N_HEADS_A = 8
HEAD_DIM_A = 64
ATTN_WIDTH = 512
KV_RANK = 128
IDX_HEADS = 4
IDX_DIM = 64
IDX_SCALE = 0.0625
TOPK_MAX = 256
Q_BLOCK = 128
N_BUCKETS = 32
MAX_DISTANCE = 128
S5_WIDTH = 512
S5_GROUP = 16
S5_GROUPS = 32
S5_STATE = 64
N_EXPERT_GROUPS = 4
EXPERTS_PER_GROUP = 8
N_EXPERTS = 32
D_EXPERT = 512
MOE_BLOCK = 128
EPS = 1e-6
SPLIT_POINTS = (512, 640, 896, 960, 964, 1476)
D_IN = 3524

kernel_name = "hybrid_dsa_s5_hiermoe_block"


def rmsnorm(x, g):
    xf = x.astype(jnp.float32)
    y = xf * lax.rsqrt(jnp.mean(xf * xf, axis=-1, keepdims=True) + EPS)
    return (y * g.astype(jnp.float32)).astype(x.dtype)


def t5_bucket(rel):
    half = N_BUCKETS // 2
    max_exact = half // 2
    ret = jnp.where(rel > 0, half, 0)
    n = jnp.abs(rel)
    nf = jnp.maximum(n, 1).astype(jnp.float32)
    large = max_exact + (jnp.log(nf / max_exact) / math.log(MAX_DISTANCE / max_exact)
                         * (half - max_exact)).astype(jnp.int32)
    large = jnp.minimum(large, half - 1)
    return ret + jnp.where(n < max_exact, n, large)


def dsa_attention(q, c, q_idx, k_idx, w_idx, w_uk, w_uv, rel_bias):
    B, S = q.shape[0], q.shape[1]
    n_blk = S // Q_BLOCK
    top_k = min(TOPK_MAX, S // 4)
    q_lat = jnp.einsum('bshd,rhd->bshr', q, w_uk) * (HEAD_DIM_A ** -0.5)

    def to_blocks(a):
        a = a.reshape((B, n_blk, Q_BLOCK) + a.shape[2:])
        return jnp.moveaxis(a, 1, 0)

    key_pos = jnp.arange(S, dtype=jnp.int32)

    def one_block(args):
        j, ql, qi, wi = args
        t = j * Q_BLOCK + jnp.arange(Q_BLOCK, dtype=jnp.int32)
        limit = (t // CHUNK + 1) * CHUNK
        act = jax.nn.relu(jnp.einsum('bqhd,bsd->bqhs', qi, k_idx))
        score = jnp.einsum('bqh,bqhs->bqs', wi, act).astype(jnp.float32)
        adm = key_pos[None, :] < limit[:, None]
        score = jnp.where(adm[None], score, -jnp.inf)
        _, idx = lax.top_k(score, top_k)
        valid = idx < limit[None, :, None]
        c_sel = jax.vmap(lambda cb, ib: cb[ib])(c, idx)
        logits = jnp.einsum('bqhr,bqkr->bqhk', ql, c_sel).astype(jnp.float32)
        bias = rel_bias[t5_bucket(idx - t[None, :, None])]
        logits = logits + jnp.moveaxis(bias, -1, 2).astype(jnp.float32)
        logits = jnp.where(valid[:, :, None, :], logits, -jnp.inf)
        p = jax.nn.softmax(logits, axis=-1).astype(c.dtype)
        return jnp.einsum('bqhk,bqkr->bqhr', p, c_sel)

    o_lat = lax.map(one_block, (jnp.arange(n_blk, dtype=jnp.int32), to_blocks(q_lat),
                                to_blocks(q_idx), to_blocks(w_idx)))
    o_lat = jnp.moveaxis(o_lat, 0, 1).reshape(B, S, N_HEADS_A, KV_RANK)
    o = jnp.einsum('bshr,rhd->bshd', o_lat, w_uv)
    return o.reshape(B, S, ATTN_WIDTH)


def _complex_affine_combine(e1, e2):
    a1r, a1i, b1r, b1i = e1
    a2r, a2i, b2r, b2i = e2
    ar = a2r * a1r - a2i * a1i
    ai = a2r * a1i + a2i * a1r
    br = a2r * b1r - a2i * b1i + b2r
    bi = a2r * b1i + a2i * b1r + b2i
    return (ar, ai, br, bi)


def s5_mixer(u, a_re, a_im, log_dt, b_re, b_im, c_re, c_im, d_skip, w_glu):
    B, S = u.shape[0], u.shape[1]
    f32 = jnp.float32
    uf = u.reshape(B, S, S5_GROUPS, S5_GROUP).astype(f32)
    dt = jnp.exp(log_dt.astype(f32))[:, None]
    ar, ai = a_re.astype(f32), a_im.astype(f32)
    mag = jnp.exp(ar * dt)
    abar_r = mag * jnp.cos(ai * dt)
    abar_i = mag * jnp.sin(ai * dt)
    nr, ni = abar_r - 1.0, abar_i
    den = ar * ar + ai * ai
    fr = (nr * ar + ni * ai) / den
    fi = (ni * ar - nr * ai) / den
    br_, bi_ = b_re.astype(f32), b_im.astype(f32)
    bb_r = fr[..., None] * br_ - fi[..., None] * bi_
    bb_i = fr[..., None] * bi_ + fi[..., None] * br_
    bu_r = jnp.einsum('bsgp,gnp->bsgn', uf, bb_r)
    bu_i = jnp.einsum('bsgp,gnp->bsgn', uf, bb_i)
    shape_a = (1, S, S5_GROUPS, S5_STATE)
    elems = (jnp.broadcast_to(abar_r, shape_a), jnp.broadcast_to(abar_i, shape_a), bu_r, bu_i)
    _, _, x_r, x_i = lax.associative_scan(_complex_affine_combine, elems, axis=1)
    y = (jnp.einsum('bsgn,gpn->bsgp', x_r, c_re.astype(f32))
         - jnp.einsum('bsgn,gpn->bsgp', x_i, c_im.astype(f32))
         + d_skip.astype(f32) * uf)
    z = jax.nn.gelu(y.reshape(B, S, S5_WIDTH).astype(u.dtype))
    val, gate = jnp.split(z @ w_glu, 2, axis=-1)
    return val * jax.nn.sigmoid(gate)


def hier_moe(h, w_rg, b_rg, w_re, b_rexp, w_gate, w_up, w_down):
    B, S, D = h.shape
    T = B * S
    f32 = jnp.float32
    xf = h.reshape(T, D)
    pg = jax.nn.softmax((xf @ w_rg).astype(f32) + b_rg.astype(f32), axis=-1)
    grp = jnp.argmax(pg, axis=-1).astype(jnp.int32)
    gval = jnp.max(pg, axis=-1)
    le = ((xf @ w_re).astype(f32) + b_rexp.astype(f32)).reshape(T, N_EXPERT_GROUPS, EXPERTS_PER_GROUP)
    le_sel = le[jnp.arange(T), grp]
    top_p, top_i = lax.top_k(jax.nn.softmax(le_sel, axis=-1), 2)
    top_p = top_p / jnp.sum(top_p, axis=-1, keepdims=True)
    weight = gval[:, None] * top_p
    eid = grp[:, None] * EXPERTS_PER_GROUP + top_i.astype(jnp.int32)

    M = 2 * T
    e_flat = eid.reshape(M)
    w_flat = weight.reshape(M)
    tok_flat = jnp.repeat(jnp.arange(T, dtype=jnp.int32), 2)
    order = jnp.argsort(e_flat)
    e_s, tok_s, w_s = e_flat[order], tok_flat[order], w_flat[order]
    counts = jnp.zeros((N_EXPERTS,), jnp.int32).at[e_flat].add(1)
    starts = jnp.cumsum(counts) - counts
    padded = (counts + MOE_BLOCK - 1) // MOE_BLOCK * MOE_BLOCK
    pad_end = jnp.cumsum(padded)
    pad_start = pad_end - padded
    dest = pad_start[e_s] + (jnp.arange(M, dtype=jnp.int32) - starts[e_s])
    n_rows = (M + N_EXPERTS * (MOE_BLOCK - 1) + MOE_BLOCK - 1) // MOE_BLOCK * MOE_BLOCK
    n_blocks = n_rows // MOE_BLOCK
    row_tok = jnp.full((n_rows,), T, jnp.int32).at[dest].set(tok_s)
    row_w = jnp.zeros((n_rows,), f32).at[dest].set(w_s)
    blk_start = jnp.arange(n_blocks, dtype=jnp.int32) * MOE_BLOCK
    blk_exp = jnp.minimum(jnp.searchsorted(pad_end, blk_start, side='right'), N_EXPERTS - 1)
    x_pad = jnp.concatenate([xf, jnp.zeros((1, D), xf.dtype)], axis=0)

    def expert_block(args):
        e, toks, wts = args
        xb = x_pad[toks]
        hb = jax.nn.silu(xb @ w_gate[e]) * (xb @ w_up[e])
        return (hb @ w_down[e]) * wts[:, None].astype(xb.dtype)

    yb = lax.map(expert_block, (blk_exp, row_tok.reshape(n_blocks, MOE_BLOCK),
                                row_w.reshape(n_blocks, MOE_BLOCK)))
    y = jnp.zeros((T + 1, D), yb.dtype).at[row_tok].add(yb.reshape(n_rows, D))[:T]
    return y.reshape(B, S, D)


def setup_inputs(seed: int = 0) -> dict:
    key = jax.random.key(seed)
    ks = jax.random.split(key, 32)
    L = DEPTH
    f32 = jnp.float32

    def w(k, shape, fan_in):
        return jax.random.normal(k, shape, f32) * (fan_in ** -0.5)

    def gain(k, shape):
        return 1.0 + 0.05 * jax.random.normal(k, shape, f32)

    n_idx = jnp.arange(S5_STATE, dtype=f32)
    a_re = -0.5 + 0.01 * jax.random.normal(ks[6], (L, S5_GROUPS, S5_STATE), f32)
    a_im = math.pi * n_idx + 0.01 * jax.random.normal(ks[7], (L, S5_GROUPS, S5_STATE), f32)
    log_dt = jax.random.uniform(ks[8], (L, S5_GROUPS), f32, math.log(0.001), math.log(0.1))
    return {
        "x": jax.random.normal(ks[0], (BATCH, SEQ, D_MODEL), f32),
        "g_mix": gain(ks[1], (L, D_MODEL)),
        "w_in": w(ks[2], (L, D_MODEL, D_IN), D_MODEL),
        "g_kv": gain(ks[3], (L, KV_RANK)),
        "w_uk": w(ks[4], (L, KV_RANK, N_HEADS_A, HEAD_DIM_A), KV_RANK),
        "w_uv": w(ks[5], (L, KV_RANK, N_HEADS_A, HEAD_DIM_A), KV_RANK),
        "rel_bias": 0.2 * jax.random.normal(ks[9], (N_BUCKETS, N_HEADS_A), f32),
        "s5_a_re": a_re,
        "s5_a_im": a_im,
        "s5_log_dt": log_dt,
        "s5_b_re": w(ks[10], (L, S5_GROUPS, S5_STATE, S5_GROUP), 2 * S5_GROUP),
        "s5_b_im": w(ks[11], (L, S5_GROUPS, S5_STATE, S5_GROUP), 2 * S5_GROUP),
        "s5_c_re": w(ks[12], (L, S5_GROUPS, S5_GROUP, S5_STATE), S5_STATE),
        "s5_c_im": w(ks[13], (L, S5_GROUPS, S5_GROUP, S5_STATE), S5_STATE),
        "s5_d": jax.random.normal(ks[14], (L, S5_GROUPS, S5_GROUP), f32),
        "w_glu": w(ks[15], (L, S5_WIDTH, 2 * S5_WIDTH), S5_WIDTH),
        "w_up_a": w(ks[16], (L, ATTN_WIDTH, D_MODEL), ATTN_WIDTH),
        "w_up_b": w(ks[17], (L, S5_WIDTH, D_MODEL), S5_WIDTH),
        "b_gate": 0.01 * jax.random.normal(ks[18], (L, 2 * D_MODEL), f32),
        "w_out": w(ks[19], (L, D_MODEL, D_MODEL), D_MODEL),
        "g_ffn": gain(ks[20], (L, D_MODEL)),
        "w_router_g": w(ks[21], (L, D_MODEL, N_EXPERT_GROUPS), D_MODEL),
        "b_router_g": 0.01 * jax.random.normal(ks[22], (L, N_EXPERT_GROUPS), f32),
        "w_router_e": w(ks[23], (L, D_MODEL, N_EXPERTS), D_MODEL),
        "b_router_e": 0.01 * jax.random.normal(ks[24], (L, N_EXPERTS), f32),
        "w_gate": w(ks[25], (L, N_EXPERTS, D_MODEL, D_EXPERT), D_MODEL),
        "w_up": w(ks[26], (L, N_EXPERTS, D_MODEL, D_EXPERT), D_MODEL),
        "w_down": w(ks[27], (L, N_EXPERTS, D_EXPERT, D_MODEL), D_EXPERT),
        "g_final": gain(ks[28], (D_MODEL,)),
    }


def reference(x, g_mix, w_in, g_kv, w_uk, w_uv, rel_bias, s5_a_re, s5_a_im, s5_log_dt,
              s5_b_re, s5_b_im, s5_c_re, s5_c_im, s5_d, w_glu, w_up_a, w_up_b, b_gate, w_out,
              g_ffn, w_router_g, b_router_g, w_router_e, b_router_e, w_gate, w_up, w_down, g_final):
    B, S = x.shape[0], x.shape[1]
    for l in range(DEPTH):
        h = rmsnorm(x, g_mix[l])
        proj = h @ w_in[l]
        q, c_raw, qi, ki, wi, u, gl = jnp.split(proj, SPLIT_POINTS, axis=-1)
        q = q.reshape(B, S, N_HEADS_A, HEAD_DIM_A)
        c = rmsnorm(c_raw, g_kv[l])
        qi = qi.reshape(B, S, IDX_HEADS, IDX_DIM)
        wi = wi * IDX_SCALE
        y_a = dsa_attention(q, c, qi, ki, wi, w_uk[l], w_uv[l], rel_bias) @ w_up_a[l]
        y_b = s5_mixer(u, s5_a_re[l], s5_a_im[l], s5_log_dt[l], s5_b_re[l], s5_b_im[l],
                       s5_c_re[l], s5_c_im[l], s5_d[l], w_glu[l]) @ w_up_b[l]
        g_a, g_b = jnp.split(jax.nn.sigmoid(gl + b_gate[l]), 2, axis=-1)
        x = x + (g_a * y_a + g_b * y_b) @ w_out[l]
        h2 = rmsnorm(x, g_ffn[l])
        x = x + hier_moe(h2, w_router_g[l], b_router_g[l], w_router_e[l], b_router_e[l],
                         w_gate[l], w_up[l], w_down[l])
    return rmsnorm(x, g_final)
```

```cpp
#include <hip/hip_runtime.h>
#include <hip/hip_cooperative_groups.h>
#include <cstdio>
#include <cstdint>
#include <cmath>
namespace cg = cooperative_groups;

#define LAS __attribute__((address_space(3)))
typedef unsigned short bf16_t;
typedef short bf16x8 __attribute__((ext_vector_type(8)));
typedef short s16x4 __attribute__((ext_vector_type(4)));
typedef float f32x4 __attribute__((ext_vector_type(4)));
typedef float f32x2 __attribute__((ext_vector_type(2)));
typedef float f32x16 __attribute__((ext_vector_type(16)));
typedef unsigned u32x4 __attribute__((ext_vector_type(4)));
typedef unsigned u32x2 __attribute__((ext_vector_type(2)));
typedef unsigned short u16x8 __attribute__((ext_vector_type(8)));

constexpr int DM = 1024, NB = 8, SEQ = 8192, MTOK = NB * SEQ;
constexpr int NT = 512, NWAVES = 8;
constexpr int NIN = 3584;
constexpr int UGP = 1152;
constexpr int MOE_ROWS = 139264;
constexpr float EPS = 1e-6f;

constexpr size_t MiB = 1ull << 20;
constexpr size_t WS_WIN = 0 * MiB, WS_WQL = 7 * MiB, WS_WO = 8 * MiB, WS_WUPA = 9 * MiB, WS_WGLU = 10 * MiB, WS_WUPB = 11 * MiB, WS_WOUT = 12 * MiB,
                 WS_WST = 14 * MiB, WS_TT = 30 * MiB, WS_WGU = 102 * MiB, WS_WD = 166 * MiB, WS_KBUF = 198 * MiB,
                 WS_GATES = 200 * MiB, WS_XS = 200 * MiB, WS_YS = 200 * MiB,
                 WS_H = 456 * MiB, WS_QLAT = 456 * MiB, WS_MIXIN = 456 * MiB,
                 WS_Q = 584 * MiB, WS_Z = 584 * MiB, WS_H2 = 584 * MiB,
                 WS_MID = 648 * MiB, WS_O = 648 * MiB,
                 WS_UG = 712 * MiB, WS_T = 712 * MiB, WS_HB = 712 * MiB,
                 WS_C = 784 * MiB, WS_IDX = 800 * MiB, WS_SST = 832 * MiB, WS_S5OUT = 848 * MiB,
                 WS_TOKINFO = 912 * MiB, WS_TOKSLOT = 914 * MiB, WS_CTL = 915 * MiB, WS_END = 916 * MiB;
constexpr int LDS_GEMM = 131072, LDS_MISC = 4096, LDS_BYTES = LDS_GEMM + LDS_MISC;

struct Params {
    const float* in[29];
    float* out;
    unsigned char* ws;
    int ph_lo, ph_hi;
};

__device__ __forceinline__ unsigned cvt_pk_bf16(float lo, float hi) { unsigned r; asm volatile("v_cvt_pk_bf16_f32 %0, %1, %2" : "=v"(r) : "v"(lo), "v"(hi)); return r; }
__device__ __forceinline__ bf16_t f2bf(float f) { unsigned u = __builtin_bit_cast(unsigned, f); return (bf16_t)((u + 0x7fffu + ((u >> 16) & 1u)) >> 16); }
__device__ __forceinline__ float bf2f(bf16_t h) { return __builtin_bit_cast(float, (unsigned)h << 16); }
__device__ __forceinline__ float bflo(unsigned w) { return __builtin_bit_cast(float, w << 16); }
__device__ __forceinline__ float bfhi(unsigned w) { return __builtin_bit_cast(float, w & 0xffff0000u); }
__device__ __forceinline__ float wave_sum(float v) {
#pragma unroll
    for (int o = 1; o < 64; o <<= 1) v += __shfl_xor(v, o);
    return v;
}
__device__ __forceinline__ float sigmoidf_(float x) { return 1.0f / (1.0f + __expf(-x)); }
__device__ __forceinline__ float gelu_tanh(float x) { const float u = 0.7978845608028654f * (x + 0.044715f * x * x * x); return x / (1.0f + __expf(-2.0f * u)); }
#define LDS_WAIT() asm volatile("s_waitcnt lgkmcnt(0)" ::: "memory")

namespace pg8 {
constexpr int BM = 256, BK = 64, HALF = 128, HTB = HALF * BK * 2, STAGE_BYTES = 8 * HTB, NXCD = 8, WGM = 8;
__host__ __device__ __forceinline__ int lds_byte(int r, int c) { const int st = (r >> 4) * 2 + (c >> 5), rr = r & 15, cc = c & 31, ob = rr * 64 + cc * 2; return st * 1024 + (ob ^ (((ob >> 9) & 1) << 5)); }
__host__ __device__ __forceinline__ void stage_rc(int b, int& R, int& C) { const int st = b / 1024, sb = b % 1024, swz = sb ^ (((sb >> 9) & 1) << 5); R = (st >> 1) * 16 + swz / 64; C = (st & 1) * 32 + (swz % 64) / 2; }
__host__ __device__ __forceinline__ int perm32(int rho) { const int n = rho >> 4, i = rho & 15; return 8 * (i >> 2) + 4 * n + (i & 3); }

struct Unit { int pm, pn, z; size_t aoff, boff; };
struct Gemm { const bf16_t* A; const bf16_t* Bt; int lda, ldb, K; };

struct Sched {
    int mode, nM, nN, nwg, G, c;
    size_t tstepA, tstepB, zstepA, zstepB;
    const LAS int* tile_e;
    __device__ __forceinline__ bool next(int i, Unit& u) const {
        const long L = (long)i * G + c; if (L >= nwg) return false;
        if (mode == 0) {
            int wgid = (int)L; { const int q = nwg / NXCD, r = nwg % NXCD, xcd = wgid % NXCD, off = wgid / NXCD; wgid = (xcd < r ? xcd * (q + 1) : r * (q + 1) + (xcd - r) * q) + off; }
            const int nig = WGM * nN, gid = wgid / nig, fm = gid * WGM, gsz = (nM - fm) < WGM ? (nM - fm) : WGM;
            u.pm = fm + ((wgid % nig) % gsz); u.pn = (wgid % nig) / gsz; u.z = 0;
            u.aoff = (size_t)u.pm * tstepA; u.boff = (size_t)u.pn * tstepB;
        } else if (mode == 1) {
            const int per = nM * nN, z = (int)L / per, r = (int)L % per;
            u.z = z; u.pm = r % nM; u.pn = r / nM;
            u.aoff = (size_t)z * zstepA + (size_t)u.pm * tstepA; u.boff = (size_t)z * zstepB + (size_t)u.pn * tstepB;
        } else {
            const int rt = (int)L / nN; u.pn = (int)L % nN; u.pm = rt; u.z = tile_e[rt];
            u.aoff = (size_t)rt * tstepA; u.boff = (size_t)u.z * zstepB + (size_t)u.pn * tstepB;
        }
        return true;
    }
};

template <class Epi>
__device__ __forceinline__ void gemm_phase(LAS unsigned char* lds, const Gemm g, const Sched& S, const Epi& E) {
    const int tid = threadIdx.x, wid = __builtin_amdgcn_readfirstlane(tid >> 6), lane = tid & 63, wr = wid >> 2, wc = wid & 3, fr = lane & 15, fq = lane >> 4;
    const int K = g.K, nt = K / BK;
    unsigned voffA[2], voffB[2];
#pragma unroll
    for (int i = 0; i < 2; ++i) { int R, C; stage_rc(tid * 16 + i * 8192, R, C); const int Rb = (R & ~31) + perm32(R & 31);
        voffA[i] = (unsigned)(R * g.lda + C) * 2u; voffB[i] = (unsigned)(Rb * g.ldb + C) * 2u; }
    const size_t kstep = (size_t)(BK * 2);
    const size_t hstepA = (size_t)HALF * g.lda * 2, hstepB = (size_t)HALF * g.ldb * 2;
    const unsigned ldsw = (unsigned)wid * 1024u;
    const int aoff = lds_byte(wr * 64 + fr, fq * 8), boff = lds_byte(wc * 32 + fr, fq * 8);
#define PG8_SA(b, h) (((b) * 2 + (h)) * HTB)
#define PG8_SB(b, h) ((4 + (b) * 2 + (h)) * HTB)
#define PG8_STAGE(bufoff, gbase, voff) do { _Pragma("unroll") for (int _i = 0; _i < 2; ++_i) \
        __builtin_amdgcn_global_load_lds((const unsigned*)((const char*)(gbase) + (voff)[_i]), (LAS unsigned*)(lds + (bufoff) + ldsw + _i * 8192), 16, 0, 0); } while (0)
#define PG8_LDA(dst, b, h) do { _Pragma("unroll") for (int m = 0; m < 4; ++m) _Pragma("unroll") for (int k = 0; k < 2; ++k) dst[m][k] = *(const LAS bf16x8*)(lds + PG8_SA(b, h) + aoff + m * 2048 + k * 1024); } while (0)
#define PG8_LDB(dst, b, h) do { _Pragma("unroll") for (int n = 0; n < 2; ++n) _Pragma("unroll") for (int k = 0; k < 2; ++k) dst[n][k] = *(const LAS bf16x8*)(lds + PG8_SB(b, h) + boff + n * 2048 + k * 1024); } while (0)
#define PG8_MMA(ai, bj, At, Bt) do { __builtin_amdgcn_s_setprio(1); _Pragma("unroll") for (int m = 0; m < 4; ++m) _Pragma("unroll") for (int n = 0; n < 2; ++n) _Pragma("unroll") for (int k = 0; k < 2; ++k) \
        acc[ai][bj][m][n] = __builtin_amdgcn_mfma_f32_16x16x32_bf16(Bt[n][k], At[m][k], acc[ai][bj][m][n], 0, 0, 0); __builtin_amdgcn_s_setprio(0); } while (0)
#define PG8_WAIT_V(n) asm volatile("s_waitcnt vmcnt(" #n ")" ::: "memory")
#define PG8_WAIT_L(n) asm volatile("s_waitcnt lgkmcnt(" #n ")" ::: "memory")
#define PG8_BAR __builtin_amdgcn_s_barrier()
#define PG8_SCHED __builtin_amdgcn_sched_barrier(0)
    Unit cur, nxt; int ui = 0;
    if (!S.next(0, cur)) return;
    f32x4 acc[2][2][4][2];
#pragma unroll
    for (int a = 0; a < 2; ++a)
#pragma unroll
        for (int b = 0; b < 2; ++b)
#pragma unroll
            for (int m = 0; m < 4; ++m)
#pragma unroll
                for (int n = 0; n < 2; ++n) acc[a][b][m][n] = (f32x4){0.f, 0.f, 0.f, 0.f};
    bf16x8 At[4][2], B0[2][2], B1[2][2];
    const char* cA = (const char*)g.A + cur.aoff; const char* cB = (const char*)g.Bt + cur.boff;
    PG8_STAGE(PG8_SB(0, 0), cB, voffB); PG8_STAGE(PG8_SB(0, 1), cB + hstepB, voffB); PG8_STAGE(PG8_SA(0, 0), cA, voffA); PG8_STAGE(PG8_SA(0, 1), cA + hstepA, voffA);
    if (wr == 1) PG8_BAR;
    PG8_WAIT_V(2); PG8_BAR;
    PG8_STAGE(PG8_SB(1, 0), cB + kstep, voffB); PG8_STAGE(PG8_SA(1, 0), cA + kstep, voffA); PG8_STAGE(PG8_SB(1, 1), cB + hstepB + kstep, voffB);
    PG8_WAIT_V(6); PG8_BAR;
    for (;;) {
        const bool has_next = S.next(ui + 1, nxt);
        const char* nA = has_next ? (const char*)g.A + nxt.aoff : cA; const char* nB = has_next ? (const char*)g.Bt + nxt.boff : cB;
        for (int t = 0; t < nt; t += 2) {
            const bool last = (t == nt - 2);
            const char* a1 = cA + (size_t)(t + 1) * kstep;
            const char* a2 = last ? nA : cA + (size_t)(t + 2) * kstep; const char* b2 = last ? nB : cB + (size_t)(t + 2) * kstep;
            const char* a3 = a2 + kstep; const char* b3 = b2 + kstep;
            PG8_LDB(B0, 0, 0); PG8_LDB(B1, 0, 1); PG8_SCHED; PG8_LDA(At, 0, 0); PG8_STAGE(PG8_SA(1, 1), a1 + hstepA, voffA);
            PG8_WAIT_V(8); PG8_WAIT_L(0); PG8_BAR; PG8_MMA(0, 0, At, B0); PG8_MMA(0, 1, At, B1); PG8_BAR; PG8_SCHED;
            PG8_LDA(At, 0, 1); PG8_STAGE(PG8_SB(0, 0), b2, voffB); PG8_STAGE(PG8_SB(0, 1), b2 + hstepB, voffB); PG8_STAGE(PG8_SA(0, 0), a2, voffA);
            PG8_WAIT_V(8); PG8_WAIT_L(0); PG8_BAR; PG8_MMA(1, 0, At, B0); PG8_MMA(1, 1, At, B1); PG8_BAR; PG8_SCHED;
            PG8_LDB(B0, 1, 0); PG8_LDB(B1, 1, 1); PG8_SCHED; PG8_LDA(At, 1, 0); PG8_STAGE(PG8_SA(0, 1), a2 + hstepA, voffA);
            PG8_WAIT_V(8); PG8_WAIT_L(0); PG8_BAR; PG8_MMA(0, 0, At, B0); PG8_MMA(0, 1, At, B1); PG8_BAR; PG8_SCHED;
            PG8_LDA(At, 1, 1); PG8_STAGE(PG8_SB(1, 0), b3, voffB); PG8_STAGE(PG8_SB(1, 1), b3 + hstepB, voffB); PG8_STAGE(PG8_SA(1, 0), a3, voffA);
            PG8_WAIT_V(8); PG8_WAIT_L(0); PG8_BAR; PG8_MMA(1, 0, At, B0); PG8_MMA(1, 1, At, B1); PG8_BAR; PG8_SCHED;
        }
        if (wr == 0) PG8_BAR;
        E(acc, cur, wr, wc, fr, fq);
        if (!has_next) break;
#pragma unroll
        for (int a = 0; a < 2; ++a)
#pragma unroll
            for (int b = 0; b < 2; ++b)
#pragma unroll
                for (int m = 0; m < 4; ++m)
#pragma unroll
                    for (int n = 0; n < 2; ++n) acc[a][b][m][n] = (f32x4){0.f, 0.f, 0.f, 0.f};
        cur = nxt; cA = nA; cB = nB; ++ui;
        if (wr == 1) PG8_BAR;
    }
    PG8_WAIT_V(0);
    PG8_BAR;
#undef PG8_SA
#undef PG8_SB
#undef PG8_STAGE
#undef PG8_LDA
#undef PG8_LDB
#undef PG8_MMA
#undef PG8_WAIT_V
#undef PG8_WAIT_L
#undef PG8_BAR
#undef PG8_SCHED
}
}
using pg8::Unit;

#define EPI_LOOP_BEGIN \
    _Pragma("unroll") for (int ai = 0; ai < 2; ++ai) _Pragma("unroll") for (int m = 0; m < 4; ++m) { const int row = u.pm * 256 + ai * 128 + wr * 64 + m * 16 + fr; (void)row;
#define EPI_LOOP_END }
__device__ __forceinline__ u32x4 pack8(f32x4 v0, f32x4 v1) { u32x4 w; w.x = cvt_pk_bf16(v0[0], v0[1]); w.y = cvt_pk_bf16(v0[2], v0[3]); w.z = cvt_pk_bf16(v1[0], v1[1]); w.w = cvt_pk_bf16(v1[2], v1[3]); return w; }

struct EpiPlain {
    bf16_t* O; int ldc; size_t zstride;
    __device__ __forceinline__ void operator()(const f32x4 (&acc)[2][2][4][2], const Unit& u, int wr, int wc, int fr, int fq) const {
        bf16_t* base = O + (size_t)u.z * zstride; const int col0 = u.pn * 256 + wc * 32 + 8 * fq;
        EPI_LOOP_BEGIN
#pragma unroll
            for (int bj = 0; bj < 2; ++bj) *(u32x4*)(base + (size_t)row * ldc + col0 + bj * 128) = pack8(acc[ai][bj][m][0], acc[ai][bj][m][1]);
        EPI_LOOP_END
    }
};
struct EpiInProj {
    bf16_t *Q, *MID, *UG, *GATES; const float* b_gate;
    __device__ __forceinline__ void operator()(const f32x4 (&acc)[2][2][4][2], const Unit& u, int wr, int wc, int fr, int fq) const {
        const int cb = u.pn * 256, cl = wc * 32 + 8 * fq;
        if (cb < 1024) {
            bf16_t* base = cb < 512 ? Q : MID; const int col0 = (cb & 511) + cl;
            EPI_LOOP_BEGIN
#pragma unroll
                for (int bj = 0; bj < 2; ++bj) *(u32x4*)(base + (size_t)row * 512 + col0 + bj * 128) = pack8(acc[ai][bj][m][0], acc[ai][bj][m][1]);
            EPI_LOOP_END
        } else if (cb < 1536) {
            EPI_LOOP_BEGIN
#pragma unroll
                for (int bj = 0; bj < 2; ++bj) { const int col = cb - 1024 + cl + bj * 128, gidx = col >> 4, q0 = col & 15;
                    *(u32x4*)(UG + ((size_t)gidx * 1024 + (row >> 6)) * UGP + (row & 63) * 16 + q0) = pack8(acc[ai][bj][m][0], acc[ai][bj][m][1]); }
            EPI_LOOP_END
        } else {
            const int col0 = cb - 1536 + cl;
            f32x4 bv[2][2];
#pragma unroll
            for (int bj = 0; bj < 2; ++bj)
#pragma unroll
                for (int n = 0; n < 2; ++n) bv[bj][n] = *(const f32x4*)(b_gate + col0 + bj * 128 + 4 * n);
            EPI_LOOP_BEGIN
#pragma unroll
                for (int bj = 0; bj < 2; ++bj) { f32x4 v0 = acc[ai][bj][m][0] + bv[bj][0], v1 = acc[ai][bj][m][1] + bv[bj][1];
#pragma unroll
                    for (int e = 0; e < 4; ++e) { v0[e] = sigmoidf_(v0[e]); v1[e] = sigmoidf_(v1[e]); }
                    *(u32x4*)(GATES + (size_t)row * 2048 + col0 + bj * 128) = pack8(v0, v1); }
            EPI_LOOP_END
        }
    }
};
struct EpiSst {
    float* SST;
    __device__ __forceinline__ void operator()(const f32x4 (&acc)[2][2][4][2], const Unit& u, int wr, int wc, int fr, int fq) const {
        const int col0 = wc * 32 + 8 * fq;
        EPI_LOOP_BEGIN
            float* p = SST + ((size_t)u.z * 1024 + row) * 128 + col0; *(f32x4*)p = acc[ai][0][m][0]; *(f32x4*)(p + 4) = acc[ai][0][m][1];
        EPI_LOOP_END
    }
};
struct EpiS5Out {
    bf16_t* Z;
    __device__ __forceinline__ void operator()(const f32x4 (&acc)[2][2][4][2], const Unit& u, int wr, int wc, int fr, int fq) const {
        EPI_LOOP_BEGIN
#pragma unroll
            for (int bj = 0; bj < 2; ++bj) { const int col = u.pn * 256 + bj * 128 + wc * 32 + 8 * fq, t = col >> 4, p0 = col & 15;
                f32x4 v0 = acc[ai][bj][m][0], v1 = acc[ai][bj][m][1];
#pragma unroll
                for (int e = 0; e < 4; ++e) { v0[e] = gelu_tanh(v0[e]); v1[e] = gelu_tanh(v1[e]); }
                *(u32x4*)(Z + ((size_t)row * 64 + t) * 512 + u.z * 16 + p0) = pack8(v0, v1); }
        EPI_LOOP_END
    }
};
template <int ACT> struct EpiGlu {
    bf16_t* O; int ldc;
    __device__ __forceinline__ void operator()(const f32x4 (&acc)[2][2][4][2], const Unit& u, int wr, int wc, int fr, int fq) const {
        const int col0 = u.pn * 128 + wc * 32 + 8 * fq;
        EPI_LOOP_BEGIN
            f32x4 r0, r1;
#pragma unroll
            for (int e = 0; e < 4; ++e) {
                if (ACT == 0) { r0[e] = acc[ai][0][m][0][e] * sigmoidf_(acc[ai][1][m][0][e]); r1[e] = acc[ai][0][m][1][e] * sigmoidf_(acc[ai][1][m][1][e]); }
                else { const float g0 = acc[ai][0][m][0][e], g1 = acc[ai][0][m][1][e]; r0[e] = g0 * sigmoidf_(g0) * acc[ai][1][m][0][e]; r1[e] = g1 * sigmoidf_(g1) * acc[ai][1][m][1][e]; } }
            *(u32x4*)(O + (size_t)row * ldc + col0) = pack8(r0, r1);
        EPI_LOOP_END
    }
};
struct EpiGateMul {
    bf16_t* O; const bf16_t* GATES; int goff; const bf16_t* prev;
    __device__ __forceinline__ void operator()(const f32x4 (&acc)[2][2][4][2], const Unit& u, int wr, int wc, int fr, int fq) const {
        const int col0 = u.pn * 256 + wc * 32 + 8 * fq;
        EPI_LOOP_BEGIN
#pragma unroll
            for (int bj = 0; bj < 2; ++bj) { const int col = col0 + bj * 128;
                const u32x4 gw = *(const u32x4*)(GATES + (size_t)row * 2048 + goff + col);
                f32x4 v0 = acc[ai][bj][m][0], v1 = acc[ai][bj][m][1];
                v0[0] *= bflo(gw.x); v0[1] *= bfhi(gw.x); v0[2] *= bflo(gw.y); v0[3] *= bfhi(gw.y); v1[0] *= bflo(gw.z); v1[1] *= bfhi(gw.z); v1[2] *= bflo(gw.w); v1[3] *= bfhi(gw.w);
                if (prev) { const u32x4 pw = *(const u32x4*)(prev + (size_t)row * 1024 + col);
                    v0[0] += bflo(pw.x); v0[1] += bfhi(pw.x); v0[2] += bflo(pw.y); v0[3] += bfhi(pw.y); v1[0] += bflo(pw.z); v1[1] += bfhi(pw.z); v1[2] += bflo(pw.w); v1[3] += bfhi(pw.w); }
                *(u32x4*)(O + (size_t)row * 1024 + col) = pack8(v0, v1); }
        EPI_LOOP_END
    }
};
struct EpiResid {
    const float* X; float* O;
    __device__ __forceinline__ void operator()(const f32x4 (&acc)[2][2][4][2], const Unit& u, int wr, int wc, int fr, int fq) const {
        const int col0 = u.pn * 256 + wc * 32 + 8 * fq;
        EPI_LOOP_BEGIN
#pragma unroll
            for (int bj = 0; bj < 2; ++bj) { const size_t off = (size_t)row * 1024 + col0 + bj * 128;
                const f32x4 x0 = *(const f32x4*)(X + off), x1 = *(const f32x4*)(X + off + 4);
                *(f32x4*)(O + off) = x0 + acc[ai][bj][m][0]; *(f32x4*)(O + off + 4) = x1 + acc[ai][bj][m][1]; }
        EPI_LOOP_END
    }
};

struct Frame {
    LAS unsigned char* lds;
    int tid, lane, wave, G, bid, gw, NGW;
    unsigned char* ws;
};

__device__ __forceinline__ pg8::Sched sched_dense(const Frame& F, int Mrows, int N, int lda, int ldb) {
    pg8::Sched S; S.mode = 0; S.nM = Mrows / 256; S.nN = N / 256; S.nwg = S.nM * S.nN; S.G = F.G; S.c = F.bid;
    S.tstepA = (size_t)256 * lda * 2; S.tstepB = (size_t)256 * ldb * 2; S.zstepA = 0; S.zstepB = 0; S.tile_e = nullptr; return S;
}
__device__ __forceinline__ pg8::Sched sched_batch(const Frame& F, int nZ, int nM, int nN, int lda, int ldb, size_t zA, size_t zB) {
    pg8::Sched S; S.mode = 1; S.nM = nM; S.nN = nN; S.nwg = nZ * nM * nN; S.G = F.G; S.c = F.bid;
    S.tstepA = (size_t)256 * lda * 2; S.tstepB = (size_t)256 * ldb * 2; S.zstepA = zA; S.zstepB = zB; S.tile_e = nullptr; return S;
}

__device__ __forceinline__ int dest_row(int mode, int n) {
    if (mode == 0) return n;
    if (mode == 1) return n < 964 ? n : n + 60;
    if (mode == 2) { const int j = n & 511, sel = n >> 9; return 256 * (j >> 7) + 128 * sel + (j & 127); }
    return 256 * (n >> 7) + 128 * (mode - 3) + (n & 127);
}
__device__ __forceinline__ void transpose_item(const float* W, int K, int N, bf16_t* WT, int mode, int item, LAS float* scr, int lane) {
    const int nblk = (N + 31) / 32, kb = item / nblk, nb = item % nblk, k0 = 64 * kb, n0 = 32 * nb;
    const int nn = n0 + (lane & 31);
#pragma unroll 8
    for (int i = 0; i < 32; ++i) { const int kk = 2 * i + (lane >> 5); scr[kk * 33 + (lane & 31)] = nn < N ? W[(size_t)(k0 + kk) * N + nn] : 0.f; }
    LDS_WAIT();
    const int c = lane & 7;
#pragma unroll
    for (int j = 0; j < 4; ++j) { const int nl = (lane >> 3) + 8 * j, n = n0 + nl; const LAS float* s = scr + (8 * c) * 33 + nl;
        u32x4 o; o.x = cvt_pk_bf16(s[0 * 33], s[1 * 33]); o.y = cvt_pk_bf16(s[2 * 33], s[3 * 33]); o.z = cvt_pk_bf16(s[4 * 33], s[5 * 33]); o.w = cvt_pk_bf16(s[6 * 33], s[7 * 33]);
        if (n < N) *(u32x4*)(WT + (size_t)dest_row(mode, n) * K + k0 + 8 * c) = o; }
    LDS_WAIT();
}
__device__ __forceinline__ void rms_row_to_bf16(const float* xrow, const float* gain, bf16_t* orow, int lane) {
    f32x4 v[4]; float s = 0.f;
#pragma unroll
    for (int j = 0; j < 4; ++j) { v[j] = *(const f32x4*)(xrow + 256 * j + 4 * lane); s += (v[j].x * v[j].x + v[j].y * v[j].y) + (v[j].z * v[j].z + v[j].w * v[j].w); }
    const float rstd = 1.0f / sqrtf(wave_sum(s) * (1.0f / 1024.0f) + EPS);
#pragma unroll
    for (int j = 0; j < 4; ++j) { const f32x4 gg = *(const f32x4*)(gain + 256 * j + 4 * lane);
        u32x2 o; o.x = cvt_pk_bf16(v[j].x * rstd * gg.x, v[j].y * rstd * gg.y); o.y = cvt_pk_bf16(v[j].z * rstd * gg.z, v[j].w * rstd * gg.w);
        *(u32x2*)(orow + 256 * j + 4 * lane) = o; }
}

__device__ __forceinline__ void s5_item(const Frame& F, const Params& p, int item) {
    const int g = item / 65, d = item % 65, tid = F.tid;
    LAS float* L = (LAS float*)F.lds;
    LAS float* pwr = L;
    LAS float* pwi = L + 64;
    LAS float* bbr = L + 128;
    LAS float* bbi = L + 128 + 1024;
    LAS float* ccr = L + 128 + 2048;
    LAS float* cci = L + 128 + 3072;
    LAS float* ffr = L + 128 + 4096;
    LAS float* ffi = L + 128 + 4096 + 64;
    const float* a_re = p.in[7]; const float* a_im = p.in[8]; const float* log_dt = p.in[9];
    const float* b_re = p.in[10]; const float* b_im = p.in[11]; const float* c_re = p.in[12]; const float* c_im = p.in[13]; const float* d_skip = p.in[14];
    if (tid < 64) {
        const int n = tid; const double dt = exp((double)log_dt[g]); const double ar = a_re[g * 64 + n], ai = a_im[g * 64 + n];
        const double mag = exp(ar * dt), abr = mag * cos(ai * dt), abi = mag * sin(ai * dt);
        const double nr = abr - 1.0, ni = abi, den = ar * ar + ai * ai;
        ffr[n] = (float)((nr * ar + ni * ai) / den); ffi[n] = (float)((ni * ar - nr * ai) / den);
        const double mg = exp(ar * dt * d); pwr[n] = (float)(mg * cos(ai * dt * d)); pwi[n] = (float)(mg * sin(ai * dt * d));
    }
    __syncthreads();
    for (int e = tid; e < 1024; e += NT) { const int n = e >> 4; const float br = b_re[g * 1024 + e], bi = b_im[g * 1024 + e], fr_ = ffr[n], fi_ = ffi[n];
        bbr[e] = fr_ * br - fi_ * bi; bbi[e] = fr_ * bi + fi_ * br; ccr[e] = c_re[g * 1024 + e]; cci[e] = c_im[g * 1024 + e]; }
    __syncthreads();
    if (d < 64) {
        if (tid < 256) { const int pp = tid >> 4, q = tid & 15; float k = 0.f;
            for (int n = 0; n < 64; ++n) { const float cr = ccr[pp * 64 + n], ci = cci[pp * 64 + n], wr_ = pwr[n], wi_ = pwi[n];
                const float tr = cr * wr_ - ci * wi_, ti = cr * wi_ + ci * wr_; k += tr * bbr[n * 16 + q] - ti * bbi[n * 16 + q]; }
            if (d == 0 && pp == q) k += d_skip[g * 16 + pp];
            ((float*)(F.ws + WS_KBUF))[((size_t)(g * 64 + d) * 16 + pp) * 16 + q] = k; }
        { const int s = 63 - d, np = tid >> 2, n = np & 63, part = np >> 6, q0 = (tid & 3) * 4; float v[4];
#pragma unroll
          for (int j = 0; j < 4; ++j) { const float br = bbr[n * 16 + q0 + j], bi = bbi[n * 16 + q0 + j]; v[j] = part ? (pwr[n] * bi + pwi[n] * br) : (pwr[n] * br - pwi[n] * bi); }
          u32x2 o; o.x = cvt_pk_bf16(v[0], v[1]); o.y = cvt_pk_bf16(v[2], v[3]);
          *(u32x2*)((bf16_t*)(F.ws + WS_WST) + ((size_t)g * 256 + np) * 1024 + s * 16 + q0) = o; }
    }
    if (d >= 1) { const int t = d - 1, pp = tid >> 5, np0 = (tid & 31) * 4; float v[4];
#pragma unroll
        for (int j = 0; j < 4; ++j) { const int np = np0 + j, n = np & 63, part = np >> 6; const float cr = ccr[pp * 64 + n], ci = cci[pp * 64 + n];
            v[j] = part ? -(cr * pwi[n] + ci * pwr[n]) : (cr * pwr[n] - ci * pwi[n]); }
        u32x2 o; o.x = cvt_pk_bf16(v[0], v[1]); o.y = cvt_pk_bf16(v[2], v[3]);
        *(u32x2*)((bf16_t*)(F.ws + WS_TT) + ((size_t)g * 1024 + t * 16 + pp) * UGP + 1024 + np0) = o; }
    if (d == 64 && tid < 64) { float* a64 = (float*)(F.ws + WS_CTL + 1024); a64[(g * 64 + tid) * 2] = pwr[tid]; a64[(g * 64 + tid) * 2 + 1] = pwi[tid]; }
    __syncthreads();
}

__device__ __forceinline__ void phase0(const Frame& F, const Params& p) {
    unsigned char* ws = F.ws;
    if (F.bid == 0 && F.tid < 32) ((int*)(ws + WS_CTL))[F.tid] = 0;
    for (int it = F.bid; it < 32 * 65; it += F.G) s5_item(F, p, it);
    {
        LAS float* scr = (LAS float*)(F.lds + F.wave * 8704);
        const int I_IN = 16 * 111, I_S = 8 * 32  , I_OUT = 16 * 32, I_E1 = 16 * 16  , I_E2 = 8 * 32  ;
        const int NITEMS = I_IN + 3 * I_S + I_OUT + 32 * (2 * I_E1 + I_E2);
        for (int it = F.gw; it < NITEMS; it += F.NGW) {
            int r = it;
            if (r < I_IN) { transpose_item(p.in[2], 1024, 3524, (bf16_t*)(ws + WS_WIN), 1, r, scr, F.lane); continue; } r -= I_IN;
            if (r < I_S) { transpose_item(p.in[16], 512, 1024, (bf16_t*)(ws + WS_WUPA), 0, r, scr, F.lane); continue; } r -= I_S;
            if (r < I_S) { transpose_item(p.in[15], 512, 1024, (bf16_t*)(ws + WS_WGLU), 2, r, scr, F.lane); continue; } r -= I_S;
            if (r < I_S) { transpose_item(p.in[17], 512, 1024, (bf16_t*)(ws + WS_WUPB), 0, r, scr, F.lane); continue; } r -= I_S;
            if (r < I_OUT) { transpose_item(p.in[19], 1024, 1024, (bf16_t*)(ws + WS_WOUT), 0, r, scr, F.lane); continue; } r -= I_OUT;
            const int per_e = 2 * I_E1 + I_E2, e = r / per_e; r -= e * per_e;
            if (r < I_E1) { transpose_item(p.in[25] + (size_t)e * 1024 * 512, 1024, 512, (bf16_t*)(ws + WS_WGU) + (size_t)e * 1024 * 1024, 3, r, scr, F.lane); continue; } r -= I_E1;
            if (r < I_E1) { transpose_item(p.in[26] + (size_t)e * 1024 * 512, 1024, 512, (bf16_t*)(ws + WS_WGU) + (size_t)e * 1024 * 1024, 4, r, scr, F.lane); continue; } r -= I_E1;
            transpose_item(p.in[27] + (size_t)e * 512 * 1024, 512, 1024, (bf16_t*)(ws + WS_WD) + (size_t)e * 1024 * 512, 0, r, scr, F.lane);
        }
    }
    {
        const long gt = (long)F.bid * NT + F.tid, GT = (long)F.G * NT;
        const u32x4 z4 = (u32x4){0u, 0u, 0u, 0u};
        for (long i = gt; i < 60 * 128; i += GT) *(u32x4*)((bf16_t*)(ws + WS_WIN) + (size_t)(964 + i / 128) * 1024 + (i % 128) * 8) = z4;
        for (long i = gt; i < 32L * 128 * 128; i += GT) { const long g = i / (128 * 128), r = (i / 128) % 128, c = i % 128; *(u32x4*)((bf16_t*)(ws + WS_WST) + ((size_t)g * 256 + 128 + r) * 1024 + c * 8) = z4; }
        const float* w_uk = p.in[4]; const float* w_uv = p.in[5];
        for (long i = gt; i < 1024L * 64; i += GT) { const int row = (int)(i / 64), c8 = (int)(i % 64) * 8, h = row >> 7, r = row & 127, hh = c8 >> 6, d0 = c8 & 63; u32x4 o = z4;
            if (h == hh) { const float* s = w_uk + ((size_t)r * 8 + h) * 64 + d0; o.x = cvt_pk_bf16(s[0] * 0.125f, s[1] * 0.125f); o.y = cvt_pk_bf16(s[2] * 0.125f, s[3] * 0.125f); o.z = cvt_pk_bf16(s[4] * 0.125f, s[5] * 0.125f); o.w = cvt_pk_bf16(s[6] * 0.125f, s[7] * 0.125f); }
            *(u32x4*)((bf16_t*)(ws + WS_WQL) + (size_t)row * 512 + c8) = o; }
        for (long i = gt; i < 512L * 128; i += GT) { const int row = (int)(i / 128), c8 = (int)(i % 128) * 8, h = row >> 6, d = row & 63, hh = c8 >> 7, r0 = c8 & 127; u32x4 o = z4;
            if (h == hh) { const float* s = w_uv + ((size_t)r0 * 8 + h) * 64 + d; o.x = cvt_pk_bf16(s[0], s[512]); o.y = cvt_pk_bf16(s[1024], s[1536]); o.z = cvt_pk_bf16(s[2048], s[2560]); o.w = cvt_pk_bf16(s[3072], s[3584]); }
            *(u32x4*)((bf16_t*)(ws + WS_WO) + (size_t)row * 1024 + c8) = o; }
    }
    for (int m = F.gw; m < MTOK; m += F.NGW) rms_row_to_bf16(p.in[0] + (size_t)m * 1024, p.in[1], (bf16_t*)(ws + WS_H) + (size_t)m * 1024, F.lane);
}

__device__ __forceinline__ void expand_tt(const Frame& F) {
    const float* kbuf = (const float*)(F.ws + WS_KBUF); bf16_t* TT = (bf16_t*)(F.ws + WS_TT);
    for (int r = F.gw; r < 32 * 1024; r += F.NGW) { const int g = r >> 10, t = (r >> 4) & 63, pp = r & 15, s = F.lane;
        u32x4 o0 = (u32x4){0u, 0u, 0u, 0u}, o1 = o0;
        if (s <= t) { const float* src = kbuf + ((size_t)(g * 64 + (t - s)) * 16 + pp) * 16; const f32x4 a = *(const f32x4*)src, b = *(const f32x4*)(src + 4), c = *(const f32x4*)(src + 8), d = *(const f32x4*)(src + 12);
            o0 = pack8(a, b); o1 = pack8(c, d); }
        bf16_t* dst = TT + (size_t)r * UGP + s * 16; *(u32x4*)dst = o0; *(u32x4*)(dst + 8) = o1; }
}

__device__ __forceinline__ void phase_cnorm(const Frame& F, const Params& p) {
    const bf16_t* MID = (const bf16_t*)(F.ws + WS_MID); bf16_t* C = (bf16_t*)(F.ws + WS_C);
    const float g0 = p.in[3][2 * F.lane], g1 = p.in[3][2 * F.lane + 1];
    for (int m = F.gw; m < MTOK; m += F.NGW) {
        const unsigned w = *(const unsigned*)(MID + (size_t)m * 512 + 2 * F.lane);
        const float a = bflo(w), b = bfhi(w);
        const float rstd = 1.0f / sqrtf(wave_sum(a * a + b * b) * (1.0f / 128.0f) + EPS);
        *(unsigned*)(C + (size_t)m * 128 + 2 * F.lane) = cvt_pk_bf16(a * rstd * g0, b * rstd * g1);
    }
}

__device__ __forceinline__ void find_thr(const LAS unsigned* hrow, unsigned need, int lane, unsigned& bin, unsigned& above) {
    const u32x4 w0 = *(const LAS u32x4*)(hrow + 8 * lane), w1 = *(const LAS u32x4*)(hrow + 8 * lane + 4);
    unsigned w[8] = {w0.x, w0.y, w0.z, w0.w, w1.x, w1.y, w1.z, w1.w};
    unsigned ls = 0;
#pragma unroll
    for (int k = 0; k < 8; ++k) ls += (w[k] & 0xffffu) + (w[k] >> 16);
    unsigned incl = ls;
#pragma unroll
    for (int off = 1; off < 64; off <<= 1) { const unsigned v = __shfl_down(incl, off); if (lane + off < 64) incl += v; }
    const unsigned excl = incl - ls;
    const bool hit = excl < need && incl >= need;
    const unsigned long long mk = __ballot(hit);
    const int src = mk ? (__ffsll((long long)mk) - 1) : 0;
    unsigned cum = excl, b = 16 * lane, ab = excl; bool found = false;
#pragma unroll
    for (int k = 7; k >= 0; --k) {
        unsigned c = w[k] >> 16; if (!found && cum + c >= need) { b = 16 * lane + 2 * k + 1; ab = cum; found = true; } cum += c;
        c = w[k] & 0xffffu;      if (!found && cum + c >= need) { b = 16 * lane + 2 * k; ab = cum; found = true; } cum += c;
    }
    bin = __shfl(b, src); above = __shfl(ab, src);
}

__device__ __forceinline__ void topk_unit(const Frame& F, int b, int ch) {
    const bf16_t* MID = (const bf16_t*)(F.ws + WS_MID); unsigned short* IDX = (unsigned short*)(F.ws + WS_IDX);
    const int lane = F.lane, w = F.wave, r = lane & 31, hi = lane >> 5;
    const int limit = 64 * (ch + 1), tok0 = b * SEQ + 64 * ch;
    LAS unsigned* hist = (LAS unsigned*)(F.lds + w * 16384);
    LAS unsigned short* outl = (LAS unsigned short*)hist;
    if (limit <= 256) {
#pragma unroll
        for (int qq = 0; qq < 8; ++qq) { const int tok = tok0 + 8 * w + qq; u32x2 o; o.x = (4u * lane) | ((4u * lane + 1u) << 16); o.y = (4u * lane + 2u) | ((4u * lane + 3u) << 16);
            *(u32x2*)(IDX + (size_t)tok * 256 + 4 * lane) = o; }
        return;
    }
    bf16x8 a[4];
    { const bf16_t* ap = MID + (size_t)(tok0 + 8 * w + (r >> 2)) * 512 + 128 + (r & 3) * 64 + 8 * hi;
#pragma unroll
      for (int s = 0; s < 4; ++s) a[s] = *(const bf16x8*)(ap + 16 * s); }
    float wv[4][4];
#pragma unroll
    for (int g = 0; g < 4; ++g) { const u32x2 ww = *(const u32x2*)(MID + (size_t)(tok0 + 8 * w + 2 * g + hi) * 512 + 448);
        wv[g][0] = bflo(ww.x) * 0.0625f; wv[g][1] = bfhi(ww.x) * 0.0625f; wv[g][2] = bflo(ww.y) * 0.0625f; wv[g][3] = bfhi(ww.y) * 0.0625f; }
    unsigned b1[4], ab1[4], R1[4], T20[4], Gc[4], Ec[4], cgt[4], ceq[4];
#pragma unroll
    for (int g = 0; g < 4; ++g) { b1[g] = 0; ab1[g] = 0; R1[g] = 256; T20[g] = 0; Gc[g] = 0; Ec[g] = 0; cgt[g] = 0; ceq[g] = 0; }
    const int ntile = limit / 32;
    const bf16_t* kbase = MID + (size_t)(b * SEQ + r) * 512 + 384 + 8 * hi;
    const unsigned lm = (1u << r) - 1u;
#pragma unroll 1
    for (int pass = 0; pass < 3; ++pass) {
        if (pass < 2) {
#pragma unroll
            for (int i = 0; i < 16; ++i) *(LAS u32x4*)(hist + 4 * lane + 256 * i) = (u32x4){0u, 0u, 0u, 0u};
        }
        LDS_WAIT();
#pragma unroll 1
        for (int kt = 0; kt < ntile; ++kt) {
            bf16x8 bk[4];
#pragma unroll
            for (int s = 0; s < 4; ++s) bk[s] = *(const bf16x8*)(kbase + (size_t)kt * 32 * 512 + 16 * s);
            f32x16 acc;
#pragma unroll
            for (int i = 0; i < 16; ++i) acc[i] = 0.f;
#pragma unroll
            for (int s = 0; s < 4; ++s) acc = __builtin_amdgcn_mfma_f32_32x32x16_bf16(a[s], bk[s], acc, 0, 0, 0);
#pragma unroll
            for (int g = 0; g < 4; ++g) {
                const float r0 = fmaxf(acc[4 * g], 0.f), r1 = fmaxf(acc[4 * g + 1], 0.f), r2 = fmaxf(acc[4 * g + 2], 0.f), r3 = fmaxf(acc[4 * g + 3], 0.f);
                const float sc = __fmaf_rn(wv[g][3], r3, __fmaf_rn(wv[g][2], r2, __fmaf_rn(wv[g][1], r1, __fmul_rn(wv[g][0], r0)))) + 0.0f;
                const unsigned uu = __float_as_uint(sc), key = (uu & 0x80000000u) ? ~uu : (uu | 0x80000000u);
                const int q = 2 * g + hi;
                if (pass == 0) { const unsigned bin = key >> 22; (void)__hip_atomic_fetch_add(hist + q * 512 + (bin >> 1), 1u << (16 * (bin & 1)), __ATOMIC_RELAXED, __HIP_MEMORY_SCOPE_WORKGROUP); }
                else if (pass == 1) { if ((key >> 22) == b1[g]) { const unsigned bin = (key >> 12) & 1023u; (void)__hip_atomic_fetch_add(hist + q * 512 + (bin >> 1), 1u << (16 * (bin & 1)), __ATOMIC_RELAXED, __HIP_MEMORY_SCOPE_WORKGROUP); } }
                else {
                    const unsigned p20 = key >> 12; const bool gt = p20 > T20[g], eq = p20 == T20[g];
                    const unsigned long long mg = __ballot(gt), me = __ballot(eq);
                    const unsigned myg = hi ? (unsigned)(mg >> 32) : (unsigned)mg, mye = hi ? (unsigned)(me >> 32) : (unsigned)me;
                    const unsigned short kidx = (unsigned short)(kt * 32 + r);
                    if (gt) { const unsigned pos = cgt[g] + __popc(myg & lm); if (pos < 256u) outl[q * 256 + pos] = kidx; }
                    cgt[g] += __popc(myg);
                    if (eq) { const unsigned rk = ceq[g] + __popc(mye & lm); if (rk < Ec[g]) { const unsigned pos = Gc[g] + rk; if (pos < 256u) outl[q * 256 + pos] = kidx; } }
                    ceq[g] += __popc(mye);
                }
            }
        }
        LDS_WAIT();
        if (pass == 0) {
#pragma unroll
            for (int qq = 0; qq < 8; ++qq) { unsigned bin, above; find_thr(hist + qq * 512, 256u, lane, bin, above);
                if ((qq & 1) == hi) { b1[qq >> 1] = bin; ab1[qq >> 1] = above; R1[qq >> 1] = 256u - above; } }
        } else if (pass == 1) {
#pragma unroll
            for (int qq = 0; qq < 8; ++qq) { const unsigned need = __shfl(R1[qq >> 1], (qq & 1) * 32); unsigned bin, above; find_thr(hist + qq * 512, need, lane, bin, above);
                if ((qq & 1) == hi) { T20[qq >> 1] = (b1[qq >> 1] << 10) | bin; Gc[qq >> 1] = ab1[qq >> 1] + above; Ec[qq >> 1] = 256u - (ab1[qq >> 1] + above); } }
        }
        LDS_WAIT();
    }
#pragma unroll
    for (int qq = 0; qq < 8; ++qq) { const int tok = tok0 + 8 * w + qq;
        if (lane < 32) *(u32x4*)(IDX + (size_t)tok * 256 + lane * 8) = *(const LAS u32x4*)(outl + qq * 256 + lane * 8); }
    LDS_WAIT();
}
__device__ __forceinline__ void phase_topk(const Frame& F) {
    for (int j = F.bid; j < 256; j += F.G) { const int b = j & 7, pp = j >> 3;
        topk_unit(F, b, 127 - pp); topk_unit(F, b, 64 + pp); topk_unit(F, b, 63 - pp); topk_unit(F, b, pp); }
}

__device__ __forceinline__ unsigned off_b(unsigned row, unsigned ch) { return 256u * row + 16u * (ch ^ (((row & 3u) << 2) | ((row >> 2) & 3u))); }
__device__ __forceinline__ s16x4 tr_read(unsigned lds_addr) { s16x4 r; asm volatile("ds_read_b64_tr_b16 %0, %1\n\ts_waitcnt lgkmcnt(0)" : "=&v"(r) : "v"(lds_addr) : "memory"); return r; }

__device__ __forceinline__ void attn_query(const Frame& F, int b, int t, LAS unsigned char* tile, LAS unsigned short* idxl, const LAS float* biasl) {
    bf16_t* QLAT = (bf16_t*)(F.ws + WS_QLAT); const bf16_t* C = (const bf16_t*)(F.ws + WS_C); const unsigned short* IDX = (const unsigned short*)(F.ws + WS_IDX);
    const int lane = F.lane, q4 = lane >> 4, hd = lane & 15;
    const int tok = b * SEQ + t, limit = (t / 64 + 1) * 64, nsel = limit < 256 ? limit : 256, ntile = nsel / 32;
    if (lane < 32) *(LAS u32x4*)(idxl + lane * 8) = *(const u32x4*)(IDX + (size_t)tok * 256 + lane * 8);
    bf16x8 bq[4];
#pragma unroll
    for (int s = 0; s < 4; ++s) { bq[s] = (bf16x8){0, 0, 0, 0, 0, 0, 0, 0}; if (hd < 8) bq[s] = *(const bf16x8*)(QLAT + (size_t)tok * 1024 + hd * 128 + 32 * s + 8 * q4); }
    LDS_WAIT();
    f32x4 accO[8];
#pragma unroll
    for (int c = 0; c < 8; ++c) accO[c] = (f32x4){0.f, 0.f, 0.f, 0.f};
    float m_run = -1e30f, l_run = 0.f;
    const bf16_t* cb = C + (size_t)b * SEQ * 128 + hd * 8;
    u32x4 pre[8];
#pragma unroll
    for (int i = 0; i < 8; ++i) { const unsigned key = idxl[q4 + 4 * i]; pre[i] = *(const u32x4*)(cb + (size_t)key * 128); }
    const unsigned tbase = (unsigned)(size_t)tile;
#pragma unroll 1
    for (int tt = 0; tt < ntile; ++tt) {
#pragma unroll
        for (int i = 0; i < 8; ++i) *(LAS u32x4*)(tile + off_b(q4 + 4 * i, hd)) = pre[i];
        if (tt + 1 < ntile) {
#pragma unroll
            for (int i = 0; i < 8; ++i) { const unsigned key = idxl[32 * (tt + 1) + q4 + 4 * i]; pre[i] = *(const u32x4*)(cb + (size_t)key * 128); }
        }
        LDS_WAIT();
        f32x4 sacc[2];
#pragma unroll
        for (int rb = 0; rb < 2; ++rb) { sacc[rb] = (f32x4){0.f, 0.f, 0.f, 0.f}; const unsigned row = 8u * (hd >> 2) + 4u * rb + (hd & 3);
#pragma unroll
            for (int s = 0; s < 4; ++s) { const bf16x8 A = *(const LAS bf16x8*)(tile + off_b(row, 4 * s + q4)); sacc[rb] = __builtin_amdgcn_mfma_f32_16x16x32_bf16(A, bq[s], sacc[rb], 0, 0, 0); } }
        const u16x8 kid = *(const LAS u16x8*)(idxl + 32 * tt + 8 * q4);
        float lg[8]; float mt = -1e30f;
#pragma unroll
        for (int j = 0; j < 8; ++j) { const int rel = (int)kid[j] - t, n = rel < 0 ? -rel : rel;
            int bucket = n < 8 ? n : min(8 + (25 - __clz(n * n)), 15); if (rel > 0) bucket += 16;
            lg[j] = sacc[j >> 2][j & 3] + biasl[bucket * 8 + (hd & 7)]; mt = fmaxf(mt, lg[j]); }
        mt = fmaxf(mt, __shfl_xor(mt, 16)); mt = fmaxf(mt, __shfl_xor(mt, 32));
        const float m_new = fmaxf(m_run, mt), alpha = __expf(m_run - m_new); m_run = m_new;
        float pj[8], ps = 0.f;
#pragma unroll
        for (int j = 0; j < 8; ++j) { pj[j] = __expf(lg[j] - m_new); ps += pj[j]; }
        l_run = l_run * alpha + ps;
#pragma unroll
        for (int c = 0; c < 8; ++c) accO[c] = accO[c] * alpha;
        u32x4 pw; pw.x = cvt_pk_bf16(pj[0], pj[1]); pw.y = cvt_pk_bf16(pj[2], pj[3]); pw.z = cvt_pk_bf16(pj[4], pj[5]); pw.w = cvt_pk_bf16(pj[6], pj[7]);
        const bf16x8 pf = __builtin_bit_cast(bf16x8, pw);
#pragma unroll
        for (int c = 0; c < 8; ++c) {
            const unsigned qq = (lane & 15) >> 2, pp = lane & 3;
            const s16x4 lo = tr_read(tbase + off_b(8u * q4 + qq, 2 * c + (pp >> 1)) + 8u * (pp & 1));
            const s16x4 hi_ = tr_read(tbase + off_b(8u * q4 + 4u + qq, 2 * c + (pp >> 1)) + 8u * (pp & 1));
            const bf16x8 A = __builtin_shufflevector(lo, hi_, 0, 1, 2, 3, 4, 5, 6, 7);
            accO[c] = __builtin_amdgcn_mfma_f32_16x16x32_bf16(A, pf, accO[c], 0, 0, 0);
        }
    }
    float lt = l_run; lt += __shfl_xor(lt, 16); lt += __shfl_xor(lt, 32);
    const float inv = 1.0f / lt;
    if (hd < 8) {
#pragma unroll
        for (int c = 0; c < 8; ++c) { u32x2 o; o.x = cvt_pk_bf16(accO[c][0] * inv, accO[c][1] * inv); o.y = cvt_pk_bf16(accO[c][2] * inv, accO[c][3] * inv);
            *(u32x2*)(QLAT + (size_t)tok * 1024 + hd * 128 + 16 * c + 4 * q4) = o; }
    }
    LDS_WAIT();
}
__device__ __forceinline__ void phase_attn(const Frame& F, const Params& p) {
    LAS unsigned char* tile = F.lds + F.wave * 8704; LAS unsigned short* idxl = (LAS unsigned short*)(tile + 8192);
    LAS float* biasl = (LAS float*)(F.lds + 8 * 8704);
    if (F.tid < 256) biasl[F.tid] = p.in[6][F.tid];
    __syncthreads();
    if (F.G % 8 == 0) {
        const int per = F.G / 8, b = F.bid & 7, slot = F.bid >> 3;
        for (int t = slot * 8 + F.wave; t < SEQ; t += per * 8) attn_query(F, b, t, tile, idxl, biasl);
    } else {
        for (int m = F.gw; m < MTOK; m += F.NGW) attn_query(F, m / SEQ, m % SEQ, tile, idxl, biasl);
    }
}

__device__ __forceinline__ void phase_scan(const Frame& F) {
    const int gt = F.bid * NT + F.tid; if (gt >= NB * 32 * 64) return;
    const int n = gt & 63, g = (gt >> 6) & 31, b = gt >> 11;
    const float* a64 = (const float*)(F.ws + WS_CTL + 1024); const float ar = a64[(g * 64 + n) * 2], ai = a64[(g * 64 + n) * 2 + 1];
    const float* SST = (const float*)(F.ws + WS_SST) + ((size_t)g * 1024 + b * 128) * 128 + n;
    bf16_t* UG = (bf16_t*)(F.ws + WS_UG) + ((size_t)g * 1024 + b * 128) * UGP + 1024 + n;
    float xr = 0.f, xi = 0.f;
    for (int c0 = 0; c0 < 128; c0 += 8) {
        float sr[8], si[8];
#pragma unroll
        for (int k = 0; k < 8; ++k) { sr[k] = SST[(size_t)(c0 + k) * 128]; si[k] = SST[(size_t)(c0 + k) * 128 + 64]; }
#pragma unroll
        for (int k = 0; k < 8; ++k) { bf16_t* u = UG + (size_t)(c0 + k) * UGP; u[0] = f2bf(xr); u[64] = f2bf(xi);
            const float nr = ar * xr - ai * xi + sr[k], ni = ar * xi + ai * xr + si[k]; xr = nr; xi = ni; }
    }
}

__device__ __forceinline__ void phase_route(const Frame& F, const Params& p) {
    const float* X1 = p.out; bf16_t* H2 = (bf16_t*)(F.ws + WS_H2); int* cnt = (int*)(F.ws + WS_CTL); int* tokinfo = (int*)(F.ws + WS_TOKINFO);
    LAS float* hrow = (LAS float*)(F.lds + F.wave * 16384);
    const int lane = F.lane, e = lane < 36 ? lane : 35;
    const float* wp = e < 4 ? p.in[21] + e : p.in[23] + (e - 4); const int wstride = e < 4 ? 4 : 32;
    const float bias = e < 4 ? p.in[22][e] : p.in[24][e - 4];
    const float* gain = p.in[20];
    for (int m0 = F.gw * 4; m0 < MTOK; m0 += F.NGW * 4) {
#pragma unroll
        for (int r = 0; r < 4; ++r) { const float* xr = X1 + (size_t)(m0 + r) * 1024; f32x4 v[4]; float s = 0.f;
#pragma unroll
            for (int j = 0; j < 4; ++j) { v[j] = *(const f32x4*)(xr + 256 * j + 4 * lane); s += (v[j].x * v[j].x + v[j].y * v[j].y) + (v[j].z * v[j].z + v[j].w * v[j].w); }
            const float rstd = 1.0f / sqrtf(wave_sum(s) * (1.0f / 1024.0f) + EPS);
#pragma unroll
            for (int j = 0; j < 4; ++j) { const f32x4 gg = *(const f32x4*)(gain + 256 * j + 4 * lane); const f32x4 h = v[j] * rstd * gg;
                u32x2 o; o.x = cvt_pk_bf16(h.x, h.y); o.y = cvt_pk_bf16(h.z, h.w); *(u32x2*)(H2 + (size_t)(m0 + r) * 1024 + 256 * j + 4 * lane) = o;
                *(LAS f32x4*)(hrow + r * 1024 + 256 * j + 4 * lane) = h; } }
        LDS_WAIT();
        float acc[4] = {0.f, 0.f, 0.f, 0.f};
#pragma unroll 2
        for (int d = 0; d < 1024; d += 4) {
            const float w0 = wp[(size_t)d * wstride], w1 = wp[(size_t)(d + 1) * wstride], w2 = wp[(size_t)(d + 2) * wstride], w3 = wp[(size_t)(d + 3) * wstride];
#pragma unroll
            for (int r = 0; r < 4; ++r) { const f32x4 h = *(const LAS f32x4*)(hrow + r * 1024 + d); acc[r] = __fmaf_rn(h.x, w0, acc[r]); acc[r] = __fmaf_rn(h.y, w1, acc[r]); acc[r] = __fmaf_rn(h.z, w2, acc[r]); acc[r] = __fmaf_rn(h.w, w3, acc[r]); }
        }
#pragma unroll
        for (int r = 0; r < 4; ++r) {
            const float lgt = acc[r] + bias;
            float gl[4]; float gm = -1e30f; int grp = 0;
#pragma unroll
            for (int k = 0; k < 4; ++k) { gl[k] = __shfl(lgt, k); if (gl[k] > gm) { gm = gl[k]; grp = k; } }
            float gs = 0.f;
#pragma unroll
            for (int k = 0; k < 4; ++k) gs += expf(gl[k] - gm);
            const float gval = 1.0f / gs;
            float el[8]; float em = -1e30f;
#pragma unroll
            for (int k = 0; k < 8; ++k) { el[k] = __shfl(lgt, 4 + grp * 8 + k); em = fmaxf(em, el[k]); }
            float pe[8];
#pragma unroll
            for (int k = 0; k < 8; ++k) pe[k] = expf(el[k] - em);
            int i1 = 0; float p1 = pe[0];
#pragma unroll
            for (int k = 1; k < 8; ++k) if (pe[k] > p1) { p1 = pe[k]; i1 = k; }
            int i2 = -1; float p2 = -1.f;
#pragma unroll
            for (int k = 0; k < 8; ++k) if (k != i1 && pe[k] > p2) { p2 = pe[k]; i2 = k; }
            const float wn = gval / (p1 + p2);
            if (lane == 0) { const int e0 = grp * 8 + i1, e1 = grp * 8 + i2; const int pos0 = atomicAdd(cnt + e0, 1), pos1 = atomicAdd(cnt + e1, 1);
                int* ti = tokinfo + (size_t)(m0 + r) * 8; ti[0] = e0; ti[1] = pos0; ti[2] = e1; ti[3] = pos1; ((float*)ti)[4] = p1 * wn; ((float*)ti)[5] = p2 * wn; }
        }
        LDS_WAIT();
    }
}
__device__ __forceinline__ int expert_base(const Frame& F, int* tot) {
    const int* cnt = (const int*)(F.ws + WS_CTL);
    const int c = F.lane < 32 ? cnt[F.lane] : 0; const int pd = (c + 255) & ~255;
    int inc = pd;
#pragma unroll
    for (int off = 1; off < 64; off <<= 1) { const int v = __shfl_up(inc, off); if (F.lane >= off) inc += v; }
    *tot = __shfl(inc, 63);
    return inc - pd;
}
__device__ __forceinline__ void phase_scatter(const Frame& F) {
    const bf16_t* H2 = (const bf16_t*)(F.ws + WS_H2); bf16_t* XS = (bf16_t*)(F.ws + WS_XS); const int* tokinfo = (const int*)(F.ws + WS_TOKINFO); int* tokslot = (int*)(F.ws + WS_TOKSLOT);
    int tot; const int base = expert_base(F, &tot);
    for (int m = F.gw; m < MTOK; m += F.NGW) {
        const int* ti = tokinfo + (size_t)m * 8; const int e0 = ti[0], pos0 = ti[1], e1 = ti[2], pos1 = ti[3];
        const int s0 = __shfl(base, e0) + pos0, s1 = __shfl(base, e1) + pos1;
        const u32x4 a = *(const u32x4*)(H2 + (size_t)m * 1024 + 8 * F.lane), bb = *(const u32x4*)(H2 + (size_t)m * 1024 + 512 + 8 * F.lane);
        *(u32x4*)(XS + (size_t)s0 * 1024 + 8 * F.lane) = a; *(u32x4*)(XS + (size_t)s0 * 1024 + 512 + 8 * F.lane) = bb;
        *(u32x4*)(XS + (size_t)s1 * 1024 + 8 * F.lane) = a; *(u32x4*)(XS + (size_t)s1 * 1024 + 512 + 8 * F.lane) = bb;
        if (F.lane == 0) { tokslot[(size_t)m * 2] = s0; tokslot[(size_t)m * 2 + 1] = s1; }
    }
}
__device__ __forceinline__ int build_tile_table(const Frame& F, LAS int* tile_e) {
    const int* cnt = (const int*)(F.ws + WS_CTL);
    int total = 0;
    for (int rt = F.tid; rt < MOE_ROWS / 256; rt += NT) { int acc = 0, e = 31;
        for (int k = 0; k < 32; ++k) { const int nt_ = (cnt[k] + 255) >> 8; if (rt >= acc && rt < acc + nt_) e = k; acc += nt_; }
        tile_e[rt] = e; }
    for (int k = 0; k < 32; ++k) total += (cnt[k] + 255) >> 8;
    __syncthreads();
    return total;
}
__device__ __forceinline__ void phase_final(const Frame& F, const Params& p) {
    const bf16_t* YS = (const bf16_t*)(F.ws + WS_YS); const int* tokinfo = (const int*)(F.ws + WS_TOKINFO); const int* tokslot = (const int*)(F.ws + WS_TOKSLOT);
    const float* gain = p.in[28]; const int lane = F.lane;
    for (int m = F.gw; m < MTOK; m += F.NGW) {
        const int s0 = tokslot[(size_t)m * 2], s1 = tokslot[(size_t)m * 2 + 1]; const float w0 = ((const float*)(tokinfo + (size_t)m * 8))[4], w1 = ((const float*)(tokinfo + (size_t)m * 8))[5];
        float* xr = p.out + (size_t)m * 1024; f32x4 v[4]; float s = 0.f;
#pragma unroll
        for (int j = 0; j < 4; ++j) { v[j] = *(const f32x4*)(xr + 256 * j + 4 * lane);
            const u32x2 a = *(const u32x2*)(YS + (size_t)s0 * 1024 + 256 * j + 4 * lane), bb = *(const u32x2*)(YS + (size_t)s1 * 1024 + 256 * j + 4 * lane);
            v[j].x += w0 * bflo(a.x) + w1 * bflo(bb.x); v[j].y += w0 * bfhi(a.x) + w1 * bfhi(bb.x); v[j].z += w0 * bflo(a.y) + w1 * bflo(bb.y); v[j].w += w0 * bfhi(a.y) + w1 * bfhi(bb.y);
            s += (v[j].x * v[j].x + v[j].y * v[j].y) + (v[j].z * v[j].z + v[j].w * v[j].w); }
        const float rstd = 1.0f / sqrtf(wave_sum(s) * (1.0f / 1024.0f) + EPS);
#pragma unroll
        for (int j = 0; j < 4; ++j) { const f32x4 gg = *(const f32x4*)(gain + 256 * j + 4 * lane); *(f32x4*)(xr + 256 * j + 4 * lane) = v[j] * rstd * gg; }
    }
}

__global__ void __launch_bounds__(NT, 2) mk_fwd(Params p) {
    extern __shared__ __attribute__((aligned(16))) unsigned char lds_raw[];
    cg::grid_group grid = cg::this_grid();
    Frame F; F.lds = (LAS unsigned char*)lds_raw; F.tid = threadIdx.x; F.lane = F.tid & 63; F.wave = __builtin_amdgcn_readfirstlane(F.tid >> 6);
    F.G = gridDim.x; F.bid = blockIdx.x; F.gw = F.bid * NWAVES + F.wave; F.NGW = F.G * NWAVES; F.ws = p.ws;
    unsigned char* ws = p.ws;
    LAS int* tile_e = (LAS int*)(F.lds + LDS_GEMM);
#define IN(k) (p.ph_lo <= (k) && (k) < p.ph_hi)
#define SYNC(k) do { if (IN(k) && IN((k) + 1)) grid.sync(); } while (0)
    if (IN(0)) phase0(F, p);
    SYNC(0);
    if (IN(1)) {
        expand_tt(F);
        __syncthreads();
        pg8::Gemm g{(const bf16_t*)(ws + WS_H), (const bf16_t*)(ws + WS_WIN), 1024, 1024, 1024}; pg8::Sched S = sched_dense(F, MTOK, NIN, 1024, 1024);
        EpiInProj E{(bf16_t*)(ws + WS_Q), (bf16_t*)(ws + WS_MID), (bf16_t*)(ws + WS_UG), (bf16_t*)(ws + WS_GATES), p.in[18]};
        pg8::gemm_phase(F.lds, g, S, E);
    }
    SYNC(1);
    if (IN(2)) {
        { pg8::Gemm g{(const bf16_t*)(ws + WS_Q), (const bf16_t*)(ws + WS_WQL), 512, 512, 512}; pg8::Sched S = sched_dense(F, MTOK, 1024, 512, 512);
          EpiPlain E{(bf16_t*)(ws + WS_QLAT), 1024, 0}; pg8::gemm_phase(F.lds, g, S, E); }
        { pg8::Gemm g{(const bf16_t*)(ws + WS_UG), (const bf16_t*)(ws + WS_WST), UGP, 1024, 1024}; pg8::Sched S = sched_batch(F, 32, 4, 1, UGP, 1024, (size_t)1024 * UGP * 2, (size_t)256 * 1024 * 2);
          EpiSst E{(float*)(ws + WS_SST)}; pg8::gemm_phase(F.lds, g, S, E); }
        __syncthreads();
        phase_cnorm(F, p);
        phase_topk(F);
    }
    SYNC(2);
    if (IN(3)) { phase_scan(F); phase_attn(F, p); }
    SYNC(3);
    if (IN(4)) {
        { pg8::Gemm g{(const bf16_t*)(ws + WS_UG), (const bf16_t*)(ws + WS_TT), UGP, UGP, UGP}; pg8::Sched S = sched_batch(F, 32, 4, 4, UGP, UGP, (size_t)1024 * UGP * 2, (size_t)1024 * UGP * 2);
          EpiS5Out E{(bf16_t*)(ws + WS_Z)}; pg8::gemm_phase(F.lds, g, S, E); }
        { pg8::Gemm g{(const bf16_t*)(ws + WS_QLAT), (const bf16_t*)(ws + WS_WO), 1024, 1024, 1024}; pg8::Sched S = sched_dense(F, MTOK, 512, 1024, 1024);
          EpiPlain E{(bf16_t*)(ws + WS_O), 512, 0}; pg8::gemm_phase(F.lds, g, S, E); }
    }
    SYNC(4);
    if (IN(5)) {
        { pg8::Gemm g{(const bf16_t*)(ws + WS_Z), (const bf16_t*)(ws + WS_WGLU), 512, 512, 512}; pg8::Sched S = sched_dense(F, MTOK, 1024, 512, 512);
          EpiGlu<0> E{(bf16_t*)(ws + WS_S5OUT), 512}; pg8::gemm_phase(F.lds, g, S, E); }
        { pg8::Gemm g{(const bf16_t*)(ws + WS_O), (const bf16_t*)(ws + WS_WUPA), 512, 512, 512}; pg8::Sched S = sched_dense(F, MTOK, 1024, 512, 512);
          EpiGateMul E{(bf16_t*)(ws + WS_T), (const bf16_t*)(ws + WS_GATES), 0, nullptr}; pg8::gemm_phase(F.lds, g, S, E); }
    }
    SYNC(5);
    if (IN(6)) {
        pg8::Gemm g{(const bf16_t*)(ws + WS_S5OUT), (const bf16_t*)(ws + WS_WUPB), 512, 512, 512}; pg8::Sched S = sched_dense(F, MTOK, 1024, 512, 512);
        EpiGateMul E{(bf16_t*)(ws + WS_MIXIN), (const bf16_t*)(ws + WS_GATES), 1024, (const bf16_t*)(ws + WS_T)}; pg8::gemm_phase(F.lds, g, S, E);
    }
    SYNC(6);
    if (IN(7)) {
        pg8::Gemm g{(const bf16_t*)(ws + WS_MIXIN), (const bf16_t*)(ws + WS_WOUT), 1024, 1024, 1024}; pg8::Sched S = sched_dense(F, MTOK, 1024, 1024, 1024);
        EpiResid E{p.in[0], p.out}; pg8::gemm_phase(F.lds, g, S, E);
    }
    SYNC(7);
    if (IN(8)) phase_route(F, p);
    SYNC(8);
    if (IN(9)) phase_scatter(F);
    SYNC(9);
    if (IN(10)) {
        const int ntiles = build_tile_table(F, tile_e);
        pg8::Gemm g{(const bf16_t*)(ws + WS_XS), (const bf16_t*)(ws + WS_WGU), 1024, 1024, 1024};
        pg8::Sched S; S.mode = 2; S.nM = ntiles; S.nN = 4; S.nwg = ntiles * 4; S.G = F.G; S.c = F.bid; S.tstepA = (size_t)256 * 1024 * 2; S.tstepB = (size_t)256 * 1024 * 2; S.zstepA = 0; S.zstepB = (size_t)1024 * 1024 * 2; S.tile_e = tile_e;
        EpiGlu<1> E{(bf16_t*)(ws + WS_HB), 512}; pg8::gemm_phase(F.lds, g, S, E);
    }
    SYNC(10);
    if (IN(11)) {
        const int ntiles = build_tile_table(F, tile_e);
        pg8::Gemm g{(const bf16_t*)(ws + WS_HB), (const bf16_t*)(ws + WS_WD), 512, 512, 512};
        pg8::Sched S; S.mode = 2; S.nM = ntiles; S.nN = 4; S.nwg = ntiles * 4; S.G = F.G; S.c = F.bid; S.tstepA = (size_t)256 * 512 * 2; S.tstepB = (size_t)256 * 512 * 2; S.zstepA = 0; S.zstepB = (size_t)1024 * 512 * 2; S.tile_e = tile_e;
        EpiPlain E{(bf16_t*)(ws + WS_YS), 1024, 0}; pg8::gemm_phase(F.lds, g, S, E);
    }
    SYNC(11);
    if (IN(12)) phase_final(F, p);
#undef IN
#undef SYNC
}

extern "C" void kernel_launch(void* const* d_in, const int* in_sizes, int n_in, void* d_out, int out_size, void* d_ws, size_t ws_size, hipStream_t stream) {
    static int grid_blocks = 0;
    if (!grid_blocks) {
        if (n_in != 29 || out_size != MTOK * DM || ws_size < WS_END) { fprintf(stderr, "kernel_launch: unexpected shapes (n_in %d out %d ws %zu, need ws %zu)\n", n_in, out_size, ws_size, (size_t)WS_END); grid_blocks = -1; return; }
        int dev = 0, cus = 0, per_cu = 0;
        (void)hipGetDevice(&dev);
        (void)hipDeviceGetAttribute(&cus, hipDeviceAttributeMultiprocessorCount, dev);
        (void)hipFuncSetAttribute((const void*)mk_fwd, hipFuncAttributeMaxDynamicSharedMemorySize, LDS_BYTES);
        (void)hipOccupancyMaxActiveBlocksPerMultiprocessor(&per_cu, (const void*)mk_fwd, NT, LDS_BYTES);
        if (per_cu < 1) { fprintf(stderr, "kernel_launch: occupancy query reports %d blocks per CU\n", per_cu); per_cu = 1; }
        grid_blocks = cus;
        fprintf(stderr, "kernel_launch: grid %d (cus %d, per_cu %d)\n", grid_blocks, cus, per_cu);
    }
    if (grid_blocks < 0) return;
    Params p{};
    for (int i = 0; i < 29; ++i) p.in[i] = (const float*)d_in[i];
    p.out = (float*)d_out; p.ws = (unsigned char*)d_ws; p.ph_lo = 0; p.ph_hi = 13;
    void* args[] = {&p};
    hipError_t e = hipLaunchCooperativeKernel((const void*)mk_fwd, dim3(grid_blocks), dim3(NT), args, LDS_BYTES, stream);
    if (e != hipSuccess) fprintf(stderr, "cooperative launch failed: %s (grid %d)\n", hipGetErrorString(e), grid_blocks);
}
```

```cpp
#include <hip/hip_runtime.h>
#include <hip/hip_cooperative_groups.h>
#include <cstdio>
#include <cstdint>
#include <cmath>
#include <type_traits>
namespace cg = cooperative_groups;

#define LAS __attribute__((address_space(3)))
typedef unsigned short bf16_t;
typedef short bf16x8 __attribute__((ext_vector_type(8)));
typedef short s16x4 __attribute__((ext_vector_type(4)));
typedef float f32x4 __attribute__((ext_vector_type(4)));
typedef float f32x2 __attribute__((ext_vector_type(2)));
typedef float f32x16 __attribute__((ext_vector_type(16)));
typedef unsigned u32x4 __attribute__((ext_vector_type(4)));
typedef unsigned u32x2 __attribute__((ext_vector_type(2)));
typedef unsigned short u16x8 __attribute__((ext_vector_type(8)));

constexpr int DM = 1024, NB = 8, SEQ = 8192, MTOK = NB * SEQ;
constexpr int NT = 512, NWAVES = 8;
constexpr int NIN = 3584;
constexpr int UGP = 1152;
constexpr int MOE_ROWS = 139264;
constexpr float EPS = 1e-6f;

constexpr size_t MiB = 1ull << 20;
constexpr size_t WS_WIN = 0 * MiB, WS_WQL = 7 * MiB, WS_WO = 8 * MiB, WS_WUPA = 9 * MiB, WS_WGLU = 10 * MiB, WS_WUPB = 11 * MiB, WS_WOUT = 12 * MiB,
                 WS_WST = 14 * MiB, WS_TT = 30 * MiB, WS_WGU = 102 * MiB, WS_WD = 166 * MiB, WS_KBUF = 198 * MiB,
                 WS_GATES = 200 * MiB, WS_XS = 200 * MiB, WS_YS = 200 * MiB,
                 WS_H = 456 * MiB, WS_QLAT = 456 * MiB, WS_MIXIN = 456 * MiB,
                 WS_Q = 584 * MiB, WS_Z = 584 * MiB, WS_H2X = 472 * MiB,
                 WS_MID = 648 * MiB, WS_O = 648 * MiB,
                 WS_UG = 712 * MiB, WS_T = 712 * MiB, WS_HB = 712 * MiB,
                 WS_C = 784 * MiB, WS_IDX = 800 * MiB, WS_SST = 832 * MiB, WS_S5OUT = 848 * MiB,
                 WS_LOGITS = 848 * MiB, WS_TOKINFO = 912 * MiB, WS_TOKSLOT = 914 * MiB, WS_CTL = 915 * MiB, WS_WR = 916 * MiB, WS_WC = 917 * MiB, WS_END = 919 * MiB;
constexpr size_t WS_BAR = WS_CTL + 65536;
constexpr int LDS_GEMM = 131072, LDS_MISC = 4096, LDS_KT = 3 * 9216, LDS_BYTES = LDS_GEMM + LDS_MISC + LDS_KT;

struct Params {
    const float* in[29];
    float* out;
    unsigned char* ws;
    int ph_lo, ph_hi;
};

__device__ __forceinline__ const float* in_ptr(int k) {
    const char __attribute__((address_space(4)))* ka = (const char __attribute__((address_space(4)))*)__builtin_amdgcn_kernarg_segment_ptr();
    asm volatile("" : "+s"(ka));
    return *(const float* const __attribute__((address_space(4)))*)(ka + 8 * k);
}
#define INP(k) in_ptr(k)
__device__ __forceinline__ unsigned cvt_pk_bf16(float lo, float hi) { unsigned r; asm volatile("v_cvt_pk_bf16_f32 %0, %1, %2" : "=v"(r) : "v"(lo), "v"(hi)); return r; }
__device__ __forceinline__ bf16_t f2bf(float f) { unsigned u = __builtin_bit_cast(unsigned, f); return (bf16_t)((u + 0x7fffu + ((u >> 16) & 1u)) >> 16); }
__device__ __forceinline__ float bf2f(bf16_t h) { return __builtin_bit_cast(float, (unsigned)h << 16); }
__device__ __forceinline__ float bflo(unsigned w) { return __builtin_bit_cast(float, w << 16); }
__device__ __forceinline__ float bfhi(unsigned w) { return __builtin_bit_cast(float, w & 0xffff0000u); }
__device__ __forceinline__ float wave_sum(float v) {
#pragma unroll
    for (int o = 1; o < 64; o <<= 1) v += __shfl_xor(v, o);
    return v;
}
__device__ __forceinline__ float sigmoidf_(float x) { return 1.0f / (1.0f + __expf(-x)); }
__device__ __forceinline__ float gelu_tanh(float x) { const float u = 0.7978845608028654f * (x + 0.044715f * x * x * x); return x / (1.0f + __expf(-2.0f * u)); }
#define LDS_WAIT() asm volatile("s_waitcnt lgkmcnt(0)" ::: "memory")
#ifdef PROBE_SET
#define RSTAMP(i) do { if (F.bid == PROBE_BID && F.tid == 0) ((LAS unsigned long long*)(F.lds + 131072 + 3072))[i] = __builtin_amdgcn_s_memrealtime(); } while (0)
#else
#define RSTAMP(i)
#endif

namespace pg8 {
constexpr int BM = 256, BK = 64, HALF = 128, HTB = HALF * BK * 2, STAGE_BYTES = 8 * HTB, NXCD = 8, WGM = 8;
__host__ __device__ __forceinline__ int lds_byte(int r, int c) { const int st = (r >> 4) * 2 + (c >> 5), rr = r & 15, cc = c & 31, ob = rr * 64 + cc * 2; return st * 1024 + (ob ^ (((ob >> 9) & 1) << 5)); }
__host__ __device__ __forceinline__ void stage_rc(int b, int& R, int& C) { const int st = b / 1024, sb = b % 1024, swz = sb ^ (((sb >> 9) & 1) << 5); R = (st >> 1) * 16 + swz / 64; C = (st & 1) * 32 + (swz % 64) / 2; }
__host__ __device__ __forceinline__ int perm32(int rho) { const int n = rho >> 4, i = rho & 15; return 8 * (i >> 2) + 4 * n + (i & 3); }

struct Unit { int pm, pn, z; size_t aoff, boff; };
struct Gemm { const bf16_t* A; const bf16_t* Bt; int lda, ldb, K; };

struct Sched {
    int mode, nM, nN, nwg, G, c;
    size_t tstepA, tstepB, zstepA, zstepB;
    const LAS int* tile_e;
    __device__ __forceinline__ bool next(int i, Unit& u) const {
        if (mode == 3) { if (i > 0) return false; u.pm = c; u.pn = 0; u.z = 0; u.aoff = (size_t)c * tstepA; u.boff = 0; return true; }
        const long L = (long)i * G + c; if (L >= nwg) return false;
        if (mode == 0) {
            int wgid = (int)L; { const int q = nwg / NXCD, r = nwg % NXCD, xcd = wgid % NXCD, off = wgid / NXCD; wgid = (xcd < r ? xcd * (q + 1) : r * (q + 1) + (xcd - r) * q) + off; }
            const int nig = WGM * nN, gid = wgid / nig, fm = gid * WGM, gsz = (nM - fm) < WGM ? (nM - fm) : WGM;
            u.pm = fm + ((wgid % nig) % gsz); u.pn = (wgid % nig) / gsz; u.z = 0;
            u.aoff = (size_t)u.pm * tstepA; u.boff = (size_t)u.pn * tstepB;
        } else if (mode == 1) {
            const int per = nM * nN, z = (int)L / per, r = (int)L % per;
            u.z = z; u.pm = r % nM; u.pn = r / nM;
            u.aoff = (size_t)z * zstepA + (size_t)u.pm * tstepA; u.boff = (size_t)z * zstepB + (size_t)u.pn * tstepB;
        } else {
            const int rt = (int)L / nN; u.pn = (int)L % nN; u.pm = rt; u.z = tile_e[rt];
            u.aoff = (size_t)rt * tstepA; u.boff = (size_t)u.z * zstepB + (size_t)u.pn * tstepB;
        }
        return true;
    }
};

template <class Epi>
__device__ __forceinline__ void gemm_phase(LAS unsigned char* lds, const Gemm g, const Sched& S, const Epi& E) {
    const int tid = threadIdx.x, wid = __builtin_amdgcn_readfirstlane(tid >> 6), lane = tid & 63, wr = wid >> 2, wc = wid & 3, fr = lane & 15, fq = lane >> 4;
    const int K = g.K, nt = K / BK;
    unsigned voffA[2], voffB[2];
#pragma unroll
    for (int i = 0; i < 2; ++i) { int R, C; stage_rc(tid * 16 + i * 8192, R, C); const int Rb = (R & ~31) + perm32(R & 31);
        voffA[i] = (unsigned)(R * g.lda + C) * 2u; voffB[i] = (unsigned)(Rb * g.ldb + C) * 2u; }
    const size_t kstep = (size_t)(BK * 2);
    const size_t hstepA = (size_t)HALF * g.lda * 2, hstepB = (size_t)HALF * g.ldb * 2;
    const unsigned ldsw = (unsigned)wid * 1024u;
    const int aoff = lds_byte(wr * 64 + fr, fq * 8), boff = lds_byte(wc * 32 + fr, fq * 8);
#define PG8_SA(b, h) (((b) * 2 + (h)) * HTB)
#define PG8_SB(b, h) ((4 + (b) * 2 + (h)) * HTB)
#define PG8_STAGE(bufoff, gbase, voff) do { _Pragma("unroll") for (int _i = 0; _i < 2; ++_i) \
        __builtin_amdgcn_global_load_lds((const unsigned*)((const char*)(gbase) + (voff)[_i]), (LAS unsigned*)(lds + (bufoff) + ldsw + _i * 8192), 16, 0, 0); } while (0)
#define PG8_LDA(dst, b, h) do { _Pragma("unroll") for (int m = 0; m < 4; ++m) _Pragma("unroll") for (int k = 0; k < 2; ++k) dst[m][k] = *(const LAS bf16x8*)(lds + PG8_SA(b, h) + aoff + m * 2048 + k * 1024); } while (0)
#define PG8_LDB(dst, b, h) do { _Pragma("unroll") for (int n = 0; n < 2; ++n) _Pragma("unroll") for (int k = 0; k < 2; ++k) dst[n][k] = *(const LAS bf16x8*)(lds + PG8_SB(b, h) + boff + n * 2048 + k * 1024); } while (0)
#define PG8_MMA(ai, bj, At, Bt) do { __builtin_amdgcn_s_setprio(1); _Pragma("unroll") for (int m = 0; m < 4; ++m) _Pragma("unroll") for (int n = 0; n < 2; ++n) _Pragma("unroll") for (int k = 0; k < 2; ++k) \
        acc[ai][bj][m][n] = __builtin_amdgcn_mfma_f32_16x16x32_bf16(Bt[n][k], At[m][k], acc[ai][bj][m][n], 0, 0, 0); __builtin_amdgcn_s_setprio(0); } while (0)
#define PG8_WAIT_V(n) asm volatile("s_waitcnt vmcnt(" #n ")" ::: "memory")
#define PG8_WAIT_L(n) asm volatile("s_waitcnt lgkmcnt(" #n ")" ::: "memory")
#define PG8_BAR __builtin_amdgcn_s_barrier()
#define PG8_SCHED __builtin_amdgcn_sched_barrier(0)
    Unit cur, nxt; int ui = 0;
    if (!S.next(0, cur)) return;
    f32x4 acc[2][2][4][2];
#pragma unroll
    for (int a = 0; a < 2; ++a)
#pragma unroll
        for (int b = 0; b < 2; ++b)
#pragma unroll
            for (int m = 0; m < 4; ++m)
#pragma unroll
                for (int n = 0; n < 2; ++n) acc[a][b][m][n] = (f32x4){0.f, 0.f, 0.f, 0.f};
    bf16x8 At[4][2], B0[2][2], B1[2][2];
    const char* cA = (const char*)g.A + cur.aoff; const char* cB = (const char*)g.Bt + cur.boff;
    PG8_STAGE(PG8_SB(0, 0), cB, voffB); PG8_STAGE(PG8_SB(0, 1), cB + hstepB, voffB); PG8_STAGE(PG8_SA(0, 0), cA, voffA); PG8_STAGE(PG8_SA(0, 1), cA + hstepA, voffA);
    if (wr == 1) PG8_BAR;
    PG8_WAIT_V(2); PG8_BAR;
    PG8_STAGE(PG8_SB(1, 0), cB + kstep, voffB); PG8_STAGE(PG8_SA(1, 0), cA + kstep, voffA); PG8_STAGE(PG8_SB(1, 1), cB + hstepB + kstep, voffB);
    PG8_WAIT_V(6); PG8_BAR;
    for (;;) {
        const bool has_next = S.next(ui + 1, nxt);
        const char* nA = has_next ? (const char*)g.A + nxt.aoff : cA; const char* nB = has_next ? (const char*)g.Bt + nxt.boff : cB;
        for (int t = 0; t < nt; t += 2) {
            const bool last = (t == nt - 2);
            const char* a1 = cA + (size_t)(t + 1) * kstep;
            const char* a2 = last ? nA : cA + (size_t)(t + 2) * kstep; const char* b2 = last ? nB : cB + (size_t)(t + 2) * kstep;
            const char* a3 = a2 + kstep; const char* b3 = b2 + kstep;
            PG8_LDB(B0, 0, 0); PG8_LDB(B1, 0, 1); PG8_SCHED; PG8_LDA(At, 0, 0); PG8_STAGE(PG8_SA(1, 1), a1 + hstepA, voffA);
            PG8_WAIT_V(8); PG8_WAIT_L(0); PG8_BAR; PG8_MMA(0, 0, At, B0); PG8_MMA(0, 1, At, B1); PG8_BAR; PG8_SCHED;
            PG8_LDA(At, 0, 1); PG8_STAGE(PG8_SB(0, 0), b2, voffB); PG8_STAGE(PG8_SB(0, 1), b2 + hstepB, voffB); PG8_STAGE(PG8_SA(0, 0), a2, voffA);
            PG8_WAIT_V(8); PG8_WAIT_L(0); PG8_BAR; PG8_MMA(1, 0, At, B0); PG8_MMA(1, 1, At, B1); PG8_BAR; PG8_SCHED;
            PG8_LDB(B0, 1, 0); PG8_LDB(B1, 1, 1); PG8_SCHED; PG8_LDA(At, 1, 0); PG8_STAGE(PG8_SA(0, 1), a2 + hstepA, voffA);
            PG8_WAIT_V(8); PG8_WAIT_L(0); PG8_BAR; PG8_MMA(0, 0, At, B0); PG8_MMA(0, 1, At, B1); PG8_BAR; PG8_SCHED;
            PG8_LDA(At, 1, 1); PG8_STAGE(PG8_SB(1, 0), b3, voffB); PG8_STAGE(PG8_SB(1, 1), b3 + hstepB, voffB); PG8_STAGE(PG8_SA(1, 0), a3, voffA);
            PG8_WAIT_V(8); PG8_WAIT_L(0); PG8_BAR; PG8_MMA(1, 0, At, B0); PG8_MMA(1, 1, At, B1); PG8_BAR; PG8_SCHED;
        }
        if (wr == 0) PG8_BAR;
        E(acc, cur, wr, wc, fr, fq);
        if (!has_next) break;
#pragma unroll
        for (int a = 0; a < 2; ++a)
#pragma unroll
            for (int b = 0; b < 2; ++b)
#pragma unroll
                for (int m = 0; m < 4; ++m)
#pragma unroll
                    for (int n = 0; n < 2; ++n) acc[a][b][m][n] = (f32x4){0.f, 0.f, 0.f, 0.f};
        cur = nxt; cA = nA; cB = nB; ++ui;
        if (wr == 1) PG8_BAR;
    }
    PG8_WAIT_V(0);
    PG8_BAR;
#undef PG8_SA
#undef PG8_SB
#undef PG8_STAGE
#undef PG8_LDA
#undef PG8_LDB
#undef PG8_MMA
#undef PG8_WAIT_V
#undef PG8_WAIT_L
#undef PG8_BAR
#undef PG8_SCHED
}
}
using pg8::Unit;

#define EPI_LOOP_BEGIN \
    _Pragma("unroll") for (int ai = 0; ai < 2; ++ai) _Pragma("unroll") for (int m = 0; m < 4; ++m) { const int row = u.pm * 256 + ai * 128 + wr * 64 + m * 16 + fr; (void)row;
#define EPI_LOOP_END }
__device__ __forceinline__ u32x4 pack8(f32x4 v0, f32x4 v1) { u32x4 w; w.x = cvt_pk_bf16(v0[0], v0[1]); w.y = cvt_pk_bf16(v0[2], v0[3]); w.z = cvt_pk_bf16(v1[0], v1[1]); w.w = cvt_pk_bf16(v1[2], v1[3]); return w; }

struct EpiPlain {
    bf16_t* O; int ldc; size_t zstride;
    __device__ __forceinline__ void operator()(const f32x4 (&acc)[2][2][4][2], const Unit& u, int wr, int wc, int fr, int fq) const {
        bf16_t* base = O + (size_t)u.z * zstride; const int col0 = u.pn * 256 + wc * 32 + 8 * fq;
        EPI_LOOP_BEGIN
#pragma unroll
            for (int bj = 0; bj < 2; ++bj) *(u32x4*)(base + (size_t)row * ldc + col0 + bj * 128) = pack8(acc[ai][bj][m][0], acc[ai][bj][m][1]);
        EPI_LOOP_END
    }
};
struct EpiInProj {
    bf16_t *Q, *MID, *UG, *GATES; const float* b_gate;
    __device__ __forceinline__ void operator()(const f32x4 (&acc)[2][2][4][2], const Unit& u, int wr, int wc, int fr, int fq) const {
        const int cb = u.pn * 256, cl = wc * 32 + 8 * fq;
        if (cb < 1024) {
            bf16_t* base = cb < 512 ? Q : MID; const int col0 = (cb & 511) + cl;
            EPI_LOOP_BEGIN
#pragma unroll
                for (int bj = 0; bj < 2; ++bj) *(u32x4*)(base + (size_t)row * 512 + col0 + bj * 128) = pack8(acc[ai][bj][m][0], acc[ai][bj][m][1]);
            EPI_LOOP_END
        } else if (cb < 1536) {
            EPI_LOOP_BEGIN
#pragma unroll
                for (int bj = 0; bj < 2; ++bj) { const int col = cb - 1024 + cl + bj * 128, gidx = col >> 4, q0 = col & 15;
                    *(u32x4*)(UG + ((size_t)gidx * 1024 + (row >> 6)) * UGP + (row & 63) * 16 + q0) = pack8(acc[ai][bj][m][0], acc[ai][bj][m][1]); }
            EPI_LOOP_END
        } else {
            const int col0 = cb - 1536 + cl;
            f32x4 bv[2][2];
#pragma unroll
            for (int bj = 0; bj < 2; ++bj)
#pragma unroll
                for (int n = 0; n < 2; ++n) bv[bj][n] = *(const f32x4*)(b_gate + col0 + bj * 128 + 4 * n);
            EPI_LOOP_BEGIN
#pragma unroll
                for (int bj = 0; bj < 2; ++bj) { f32x4 v0 = acc[ai][bj][m][0] + bv[bj][0], v1 = acc[ai][bj][m][1] + bv[bj][1];
#pragma unroll
                    for (int e = 0; e < 4; ++e) { v0[e] = sigmoidf_(v0[e]); v1[e] = sigmoidf_(v1[e]); }
                    *(u32x4*)(GATES + (size_t)row * 2048 + col0 + bj * 128) = pack8(v0, v1); }
            EPI_LOOP_END
        }
    }
};
struct EpiSst {
    float* SST;
    __device__ __forceinline__ void operator()(const f32x4 (&acc)[2][2][4][2], const Unit& u, int wr, int wc, int fr, int fq) const {
        const int col0 = wc * 32 + 8 * fq;
        EPI_LOOP_BEGIN
            float* p = SST + ((size_t)u.z * 1024 + row) * 128 + col0; *(f32x4*)p = acc[ai][0][m][0]; *(f32x4*)(p + 4) = acc[ai][0][m][1];
        EPI_LOOP_END
    }
};
struct EpiS5Out {
    bf16_t* Z;
    __device__ __forceinline__ void operator()(const f32x4 (&acc)[2][2][4][2], const Unit& u, int wr, int wc, int fr, int fq) const {
        EPI_LOOP_BEGIN
#pragma unroll
            for (int bj = 0; bj < 2; ++bj) { const int col = u.pn * 256 + bj * 128 + wc * 32 + 8 * fq, t = col >> 4, p0 = col & 15;
                f32x4 v0 = acc[ai][bj][m][0], v1 = acc[ai][bj][m][1];
#pragma unroll
                for (int e = 0; e < 4; ++e) { v0[e] = gelu_tanh(v0[e]); v1[e] = gelu_tanh(v1[e]); }
                *(u32x4*)(Z + ((size_t)row * 64 + t) * 512 + u.z * 16 + p0) = pack8(v0, v1); }
        EPI_LOOP_END
    }
};
template <int ACT> struct EpiGlu {
    bf16_t* O; int ldc;
    __device__ __forceinline__ void operator()(const f32x4 (&acc)[2][2][4][2], const Unit& u, int wr, int wc, int fr, int fq) const {
        const int col0 = u.pn * 128 + wc * 32 + 8 * fq;
        EPI_LOOP_BEGIN
            f32x4 r0, r1;
#pragma unroll
            for (int e = 0; e < 4; ++e) {
                if (ACT == 0) { r0[e] = acc[ai][0][m][0][e] * sigmoidf_(acc[ai][1][m][0][e]); r1[e] = acc[ai][0][m][1][e] * sigmoidf_(acc[ai][1][m][1][e]); }
                else { const float g0 = acc[ai][0][m][0][e], g1 = acc[ai][0][m][1][e]; r0[e] = g0 * sigmoidf_(g0) * acc[ai][1][m][0][e]; r1[e] = g1 * sigmoidf_(g1) * acc[ai][1][m][1][e]; } }
            *(u32x4*)(O + (size_t)row * ldc + col0) = pack8(r0, r1);
        EPI_LOOP_END
    }
};
struct EpiGateMul {
    bf16_t* O; const bf16_t* GATES; int goff; const bf16_t* prev;
    __device__ __forceinline__ void operator()(const f32x4 (&acc)[2][2][4][2], const Unit& u, int wr, int wc, int fr, int fq) const {
        const int col0 = u.pn * 256 + wc * 32 + 8 * fq;
#pragma unroll
        for (int ai = 0; ai < 2; ++ai) {
            u32x4 gw[4][2], pw[4][2];
#pragma unroll
            for (int m = 0; m < 4; ++m)
#pragma unroll
                for (int bj = 0; bj < 2; ++bj) { const int row = u.pm * 256 + ai * 128 + wr * 64 + m * 16 + fr, col = col0 + bj * 128;
                    gw[m][bj] = *(const u32x4*)(GATES + (size_t)row * 2048 + goff + col);
                    pw[m][bj] = prev ? *(const u32x4*)(prev + (size_t)row * 1024 + col) : (u32x4){0u, 0u, 0u, 0u}; }
#pragma unroll
            for (int m = 0; m < 4; ++m)
#pragma unroll
                for (int bj = 0; bj < 2; ++bj) { const int row = u.pm * 256 + ai * 128 + wr * 64 + m * 16 + fr, col = col0 + bj * 128;
                    f32x4 v0 = acc[ai][bj][m][0], v1 = acc[ai][bj][m][1]; const u32x4 g4 = gw[m][bj], p4 = pw[m][bj];
                    v0[0] = v0[0] * bflo(g4.x) + bflo(p4.x); v0[1] = v0[1] * bfhi(g4.x) + bfhi(p4.x); v0[2] = v0[2] * bflo(g4.y) + bflo(p4.y); v0[3] = v0[3] * bfhi(g4.y) + bfhi(p4.y);
                    v1[0] = v1[0] * bflo(g4.z) + bflo(p4.z); v1[1] = v1[1] * bfhi(g4.z) + bfhi(p4.z); v1[2] = v1[2] * bflo(g4.w) + bflo(p4.w); v1[3] = v1[3] * bfhi(g4.w) + bfhi(p4.w);
                    *(u32x4*)(O + (size_t)row * 1024 + col) = pack8(v0, v1); }
        }
    }
};
struct EpiRouter {
    float* LOG;
    __device__ __forceinline__ void operator()(const f32x4 (&acc)[2][2][4][2], const Unit& u, int wr, int wc, int fr, int fq) const {
        if (wc == 0 || (wc == 1 && fq == 0)) { const int col0 = wc * 32 + 8 * fq;
            EPI_LOOP_BEGIN
                float* o = LOG + (size_t)row * 64 + col0; *(f32x4*)o = acc[ai][0][m][0] + acc[ai][1][m][0]; *(f32x4*)(o + 4) = acc[ai][0][m][1] + acc[ai][1][m][1];
            EPI_LOOP_END }
    }
};
struct EpiResid {
    const float* X; float* O;
    __device__ __forceinline__ void operator()(const f32x4 (&acc)[2][2][4][2], const Unit& u, int wr, int wc, int fr, int fq) const {
        const int col0 = u.pn * 256 + wc * 32 + 8 * fq;
#pragma unroll
        for (int ai = 0; ai < 2; ++ai) {
            f32x4 xv[4][2][2];
#pragma unroll
            for (int m = 0; m < 4; ++m)
#pragma unroll
                for (int bj = 0; bj < 2; ++bj) { const size_t off = (size_t)(u.pm * 256 + ai * 128 + wr * 64 + m * 16 + fr) * 1024 + col0 + bj * 128;
                    xv[m][bj][0] = *(const f32x4*)(X + off); xv[m][bj][1] = *(const f32x4*)(X + off + 4); }
#pragma unroll
            for (int m = 0; m < 4; ++m)
#pragma unroll
                for (int bj = 0; bj < 2; ++bj) { const size_t off = (size_t)(u.pm * 256 + ai * 128 + wr * 64 + m * 16 + fr) * 1024 + col0 + bj * 128;
                    *(f32x4*)(O + off) = xv[m][bj][0] + acc[ai][bj][m][0]; *(f32x4*)(O + off + 4) = xv[m][bj][1] + acc[ai][bj][m][1]; }
        }
    }
};

struct Frame {
    LAS unsigned char* lds;
    int tid, lane, wave, G, bid, gw, NGW;
    unsigned char* ws;
};

__device__ __forceinline__ pg8::Sched sched_dense(const Frame& F, int Mrows, int N, int lda, int ldb) {
    pg8::Sched S; S.mode = 0; S.nM = Mrows / 256; S.nN = N / 256; S.nwg = S.nM * S.nN; S.G = F.G; S.c = F.bid;
    S.tstepA = (size_t)256 * lda * 2; S.tstepB = (size_t)256 * ldb * 2; S.zstepA = 0; S.zstepB = 0; S.tile_e = nullptr; return S;
}
__device__ __forceinline__ pg8::Sched sched_batch(const Frame& F, int nZ, int nM, int nN, int lda, int ldb, size_t zA, size_t zB) {
    pg8::Sched S; S.mode = 1; S.nM = nM; S.nN = nN; S.nwg = nZ * nM * nN; S.G = F.G; S.c = F.bid;
    S.tstepA = (size_t)256 * lda * 2; S.tstepB = (size_t)256 * ldb * 2; S.zstepA = zA; S.zstepB = zB; S.tile_e = nullptr; return S;
}

__device__ __forceinline__ int dest_row(int mode, int n) {
    if (mode == 0) return n;
    if (mode == 1) return n < 964 ? n : n + 60;
    if (mode == 2) { const int j = n & 511, sel = n >> 9; return 256 * (j >> 7) + 128 * sel + (j & 127); }
    return 256 * (n >> 7) + 128 * (mode - 3) + (n & 127);
}
struct TrItem { const float* W; bf16_t* WT; int K, N, mode, k0, n0; };
__device__ __forceinline__ void transpose_load(const TrItem& t, f32x4 (&v)[8], int lane) {
    const int n = t.n0 + 4 * (lane & 7);
#pragma unroll
    for (int i = 0; i < 8; ++i) { const int kk = 8 * i + (lane >> 3); v[i] = n < t.N ? *(const f32x4*)(t.W + (size_t)(t.k0 + kk) * t.N + n) : (f32x4){0.f, 0.f, 0.f, 0.f}; }
}
__device__ __forceinline__ void transpose_store(const TrItem& t, const f32x4 (&v)[8], LAS float* scr, int lane) {
#pragma unroll
    for (int i = 0; i < 8; ++i) { LAS float* d = scr + (8 * i + (lane >> 3)) * 33 + 4 * (lane & 7); d[0] = v[i].x; d[1] = v[i].y; d[2] = v[i].z; d[3] = v[i].w; }
    LDS_WAIT();
    const int c = lane & 7;
#pragma unroll
    for (int j = 0; j < 4; ++j) { const int nl = (lane >> 3) + 8 * j, n = t.n0 + nl; const LAS float* s = scr + (8 * c) * 33 + nl;
        u32x4 o; o.x = cvt_pk_bf16(s[0 * 33], s[1 * 33]); o.y = cvt_pk_bf16(s[2 * 33], s[3 * 33]); o.z = cvt_pk_bf16(s[4 * 33], s[5 * 33]); o.w = cvt_pk_bf16(s[6 * 33], s[7 * 33]);
        if (n < t.N) *(u32x4*)(t.WT + (size_t)dest_row(t.mode, n) * t.K + t.k0 + 8 * c) = o; }
    LDS_WAIT();
}
__device__ __forceinline__ void rms_row_to_bf16(const float* xrow, const float* gain, bf16_t* orow, int lane) {
    f32x4 v[4]; float s = 0.f;
#pragma unroll
    for (int j = 0; j < 4; ++j) { v[j] = *(const f32x4*)(xrow + 256 * j + 4 * lane); s += (v[j].x * v[j].x + v[j].y * v[j].y) + (v[j].z * v[j].z + v[j].w * v[j].w); }
    const float rstd = 1.0f / sqrtf(wave_sum(s) * (1.0f / 1024.0f) + EPS);
#pragma unroll
    for (int j = 0; j < 4; ++j) { const f32x4 gg = *(const f32x4*)(gain + 256 * j + 4 * lane);
        u32x2 o; o.x = cvt_pk_bf16(v[j].x * rstd * gg.x, v[j].y * rstd * gg.y); o.y = cvt_pk_bf16(v[j].z * rstd * gg.z, v[j].w * rstd * gg.w);
        *(u32x2*)(orow + 256 * j + 4 * lane) = o; }
}

__device__ __forceinline__ void s5_item(const Frame& F, const Params& p, int item) {
    const int g = item / 65, d = item % 65, tid = F.tid;
    LAS float* L = (LAS float*)F.lds;
    LAS float* pwr = L;
    LAS float* pwi = L + 64;
    LAS float* bbr = L + 128;
    LAS float* bbi = L + 128 + 1024;
    LAS float* ccr = L + 128 + 2048;
    LAS float* cci = L + 128 + 3072;
    LAS float* ffr = L + 128 + 4096;
    LAS float* ffi = L + 128 + 4096 + 64;
    const float* a_re = INP(7); const float* a_im = INP(8); const float* log_dt = INP(9);
    const float* b_re = INP(10); const float* b_im = INP(11); const float* c_re = INP(12); const float* c_im = INP(13); const float* d_skip = INP(14);
    if (tid < 64) {
        const int n = tid; const double dt = exp((double)log_dt[g]); const double ar = a_re[g * 64 + n], ai = a_im[g * 64 + n];
        const double mag = exp(ar * dt), abr = mag * cos(ai * dt), abi = mag * sin(ai * dt);
        const double nr = abr - 1.0, ni = abi, den = ar * ar + ai * ai;
        ffr[n] = (float)((nr * ar + ni * ai) / den); ffi[n] = (float)((ni * ar - nr * ai) / den);
        const double mg = exp(ar * dt * d); pwr[n] = (float)(mg * cos(ai * dt * d)); pwi[n] = (float)(mg * sin(ai * dt * d));
    }
    __syncthreads();
    for (int e = tid; e < 1024; e += NT) { const int n = e >> 4; const float br = b_re[g * 1024 + e], bi = b_im[g * 1024 + e], fr_ = ffr[n], fi_ = ffi[n];
        bbr[e] = fr_ * br - fi_ * bi; bbi[e] = fr_ * bi + fi_ * br; ccr[e] = c_re[g * 1024 + e]; cci[e] = c_im[g * 1024 + e]; }
    __syncthreads();
    if (d < 64) {
        if (tid < 256) { const int pp = tid >> 4, q = tid & 15; float k = 0.f;
            for (int n = 0; n < 64; ++n) { const float cr = ccr[pp * 64 + n], ci = cci[pp * 64 + n], wr_ = pwr[n], wi_ = pwi[n];
                const float tr = cr * wr_ - ci * wi_, ti = cr * wi_ + ci * wr_; k += tr * bbr[n * 16 + q] - ti * bbi[n * 16 + q]; }
            if (d == 0 && pp == q) k += d_skip[g * 16 + pp];
            ((float*)(F.ws + WS_KBUF))[((size_t)(g * 64 + d) * 16 + pp) * 16 + q] = k; }
        { const int s = 63 - d, np = tid >> 2, n = np & 63, part = np >> 6, q0 = (tid & 3) * 4; float v[4];
#pragma unroll
          for (int j = 0; j < 4; ++j) { const float br = bbr[n * 16 + q0 + j], bi = bbi[n * 16 + q0 + j]; v[j] = part ? (pwr[n] * bi + pwi[n] * br) : (pwr[n] * br - pwi[n] * bi); }
          u32x2 o; o.x = cvt_pk_bf16(v[0], v[1]); o.y = cvt_pk_bf16(v[2], v[3]);
          *(u32x2*)((bf16_t*)(F.ws + WS_WST) + ((size_t)g * 256 + np) * 1024 + s * 16 + q0) = o; }
    }
    if (d >= 1) { const int t = d - 1, pp = tid >> 5, np0 = (tid & 31) * 4; float v[4];
#pragma unroll
        for (int j = 0; j < 4; ++j) { const int np = np0 + j, n = np & 63, part = np >> 6; const float cr = ccr[pp * 64 + n], ci = cci[pp * 64 + n];
            v[j] = part ? -(cr * pwi[n] + ci * pwr[n]) : (cr * pwr[n] - ci * pwi[n]); }
        u32x2 o; o.x = cvt_pk_bf16(v[0], v[1]); o.y = cvt_pk_bf16(v[2], v[3]);
        *(u32x2*)((bf16_t*)(F.ws + WS_TT) + ((size_t)g * 1024 + t * 16 + pp) * UGP + 1024 + np0) = o; }
    if (d == 64 && tid < 64) { float* a64 = (float*)(F.ws + WS_CTL + 1024); a64[(g * 64 + tid) * 2] = pwr[tid]; a64[(g * 64 + tid) * 2 + 1] = pwi[tid]; }
    __syncthreads();
}

__device__ __forceinline__ void phase0(const Frame& F, const Params& p) {
    unsigned char* ws = F.ws;
    if (F.bid == 0 && F.tid < 80) ((int*)(ws + WS_CTL))[F.tid] = 0;
    for (int it = F.bid; it < 32 * 65; it += F.G) s5_item(F, p, it);
    RSTAMP(35);
    {
        LAS float* scr = (LAS float*)(F.lds + F.wave * 8704);
        const int I_IN = 16 * 111, I_S = 8 * 32  , I_OUT = 16 * 32, I_E1 = 16 * 16  , I_E2 = 8 * 32  ;
        const int NITEMS = I_IN + 3 * I_S + I_OUT + 32 * (2 * I_E1 + I_E2);
        auto decode = [&](int it) {
            TrItem t; int r = it;
            auto fill = [&](const float* W, int K, int N, bf16_t* WT, int mode, int rr) { const int nblk = (N + 31) / 32; t.W = W; t.WT = WT; t.K = K; t.N = N; t.mode = mode; t.k0 = 64 * (rr / nblk); t.n0 = 32 * (rr % nblk); };
            if (r < I_IN) { fill(INP(2), 1024, 3524, (bf16_t*)(ws + WS_WIN), 1, r); return t; } r -= I_IN;
            if (r < I_S) { fill(INP(16), 512, 1024, (bf16_t*)(ws + WS_WUPA), 0, r); return t; } r -= I_S;
            if (r < I_S) { fill(INP(15), 512, 1024, (bf16_t*)(ws + WS_WGLU), 2, r); return t; } r -= I_S;
            if (r < I_S) { fill(INP(17), 512, 1024, (bf16_t*)(ws + WS_WUPB), 0, r); return t; } r -= I_S;
            if (r < I_OUT) { fill(INP(19), 1024, 1024, (bf16_t*)(ws + WS_WOUT), 0, r); return t; } r -= I_OUT;
            const int per_e = 2 * I_E1 + I_E2, e = r / per_e; r -= e * per_e;
            if (r < I_E1) { fill(INP(25) + (size_t)e * 1024 * 512, 1024, 512, (bf16_t*)(ws + WS_WGU) + (size_t)e * 1024 * 1024, 3, r); return t; } r -= I_E1;
            if (r < I_E1) { fill(INP(26) + (size_t)e * 1024 * 512, 1024, 512, (bf16_t*)(ws + WS_WGU) + (size_t)e * 1024 * 1024, 4, r); return t; } r -= I_E1;
            fill(INP(27) + (size_t)e * 512 * 1024, 512, 1024, (bf16_t*)(ws + WS_WD) + (size_t)e * 1024 * 512, 0, r); return t;
        };
        int it = F.gw;
        if (it < NITEMS) {
            TrItem cur = decode(it); f32x4 v[8]; transpose_load(cur, v, F.lane);
            for (;;) { const int nit = it + F.NGW; const bool more = nit < NITEMS;
                f32x4 vn[8]; const TrItem nx = decode(more ? nit : it); transpose_load(nx, vn, F.lane);
                transpose_store(cur, v, scr, F.lane);
                if (!more) break;
                cur = nx; it = nit;
#pragma unroll
                for (int i = 0; i < 8; ++i) v[i] = vn[i]; }
        }
    }
    RSTAMP(36);
    {
        const long gt = (long)F.bid * NT + F.tid, GT = (long)F.G * NT;
        const u32x4 z4 = (u32x4){0u, 0u, 0u, 0u};
        for (long i = gt; i < 60 * 128; i += GT) *(u32x4*)((bf16_t*)(ws + WS_WIN) + (size_t)(964 + i / 128) * 1024 + (i % 128) * 8) = z4;
        for (long i = gt; i < 32L * 128 * 128; i += GT) { const long g = i / (128 * 128), r = (i / 128) % 128, c = i % 128; *(u32x4*)((bf16_t*)(ws + WS_WST) + ((size_t)g * 256 + 128 + r) * 1024 + c * 8) = z4; }
        const float* w_uk = INP(4); const float* w_uv = INP(5);
        for (long i = gt; i < 1024L * 64; i += GT) { const int row = (int)(i / 64), c8 = (int)(i % 64) * 8, h = row >> 7, r = row & 127, hh = c8 >> 6, d0 = c8 & 63; u32x4 o = z4;
            if (h == hh) { const float* s = w_uk + ((size_t)r * 8 + h) * 64 + d0; const float qs = 0.125f * 1.44269504f;     o.x = cvt_pk_bf16(s[0] * qs, s[1] * qs); o.y = cvt_pk_bf16(s[2] * qs, s[3] * qs); o.z = cvt_pk_bf16(s[4] * qs, s[5] * qs); o.w = cvt_pk_bf16(s[6] * qs, s[7] * qs); }
            *(u32x4*)((bf16_t*)(ws + WS_WQL) + (size_t)row * 512 + c8) = o; }
        for (long i = gt; i < 1024L * 64; i += GT) { const int row = (int)(i / 64), c8 = (int)(i % 64) * 8, h = row >> 7, r = row & 127, hh = c8 >> 6, d0 = c8 & 63; u32x4 o = z4;
            if (h == hh) { const float* s = w_uv + ((size_t)r * 8 + h) * 64 + d0; o.x = cvt_pk_bf16(s[0], s[1]); o.y = cvt_pk_bf16(s[2], s[3]); o.z = cvt_pk_bf16(s[4], s[5]); o.w = cvt_pk_bf16(s[6], s[7]); }
            *(u32x4*)((bf16_t*)(ws + WS_WO) + (size_t)row * 512 + c8) = o; }
    }
    {
        const long gt = (long)F.bid * NT + F.tid, GT = (long)F.G * NT;
        for (long i = gt; i < 256L * 256; i += GT) { const int row = (int)(i >> 8), c8 = (int)(i & 255) * 8, e = row & 127, lo = row >> 7, half = c8 >> 10, d0 = c8 & 1023;
            u32x4 o = (u32x4){0u, 0u, 0u, 0u};
            if (e < 36 && !(lo && half)) { float v[8];
#pragma unroll
                for (int j = 0; j < 8; ++j) { const float w = e < 4 ? INP(21)[(size_t)(d0 + j) * 4 + e] : INP(23)[(size_t)(d0 + j) * 32 + (e - 4)]; const float h = bf2f(f2bf(w)); v[j] = lo ? (w - h) : h; }
                o.x = cvt_pk_bf16(v[0], v[1]); o.y = cvt_pk_bf16(v[2], v[3]); o.z = cvt_pk_bf16(v[4], v[5]); o.w = cvt_pk_bf16(v[6], v[7]); }
            *(u32x4*)((bf16_t*)(ws + WS_WR) + (size_t)row * 2048 + c8) = o; }
    }
    RSTAMP(37);
    { const float* X = INP(0); const float* gain = INP(1); bf16_t* H = (bf16_t*)(ws + WS_H); const int lane = F.lane;
      for (int m0 = F.gw * 4; m0 < MTOK; m0 += F.NGW * 4) {
        f32x4 v[4][4]; float ss[4];
#pragma unroll
        for (int u = 0; u < 4; ++u)
#pragma unroll
            for (int j = 0; j < 4; ++j) v[u][j] = *(const f32x4*)(X + (size_t)(m0 + u) * 1024 + 256 * j + 4 * lane);
#pragma unroll
        for (int u = 0; u < 4; ++u) { float s_ = 0.f;
#pragma unroll
            for (int j = 0; j < 4; ++j) s_ += (v[u][j].x * v[u][j].x + v[u][j].y * v[u][j].y) + (v[u][j].z * v[u][j].z + v[u][j].w * v[u][j].w);
            ss[u] = s_; }
#pragma unroll
        for (int o = 1; o < 64; o <<= 1) {
#pragma unroll
            for (int u = 0; u < 4; ++u) ss[u] += __shfl_xor(ss[u], o); }
#pragma unroll
        for (int u = 0; u < 4; ++u) { const float rstd = 1.0f / sqrtf(ss[u] * (1.0f / 1024.0f) + EPS);
#pragma unroll
            for (int j = 0; j < 4; ++j) { const f32x4 gg = *(const f32x4*)(gain + 256 * j + 4 * lane);
                u32x2 o; o.x = cvt_pk_bf16(v[u][j].x * rstd * gg.x, v[u][j].y * rstd * gg.y); o.y = cvt_pk_bf16(v[u][j].z * rstd * gg.z, v[u][j].w * rstd * gg.w);
                *(u32x2*)(H + (size_t)(m0 + u) * 1024 + 256 * j + 4 * lane) = o; } }
      } }
}

__device__ __forceinline__ void expand_tt(const Frame& F) {
    const float* kbuf = (const float*)(F.ws + WS_KBUF); bf16_t* TT = (bf16_t*)(F.ws + WS_TT);
    for (int r0 = F.gw * 4; r0 < 32 * 1024; r0 += F.NGW * 4) { const int s = F.lane;
        f32x4 q[4][4];
#pragma unroll
        for (int u = 0; u < 4; ++u) { const int r = r0 + u, g = r >> 10, t = (r >> 4) & 63, pp = r & 15; const int dd = s <= t ? t - s : 0;
            const float* src = kbuf + ((size_t)(g * 64 + dd) * 16 + pp) * 16;
#pragma unroll
            for (int j = 0; j < 4; ++j) q[u][j] = *(const f32x4*)(src + 4 * j); }
#pragma unroll
        for (int u = 0; u < 4; ++u) { const int r = r0 + u, t = (r >> 4) & 63;
            u32x4 o0 = pack8(q[u][0], q[u][1]), o1 = pack8(q[u][2], q[u][3]);
            if (s > t) { o0 = (u32x4){0u, 0u, 0u, 0u}; o1 = o0; }
            bf16_t* dst = TT + (size_t)r * UGP + s * 16; *(u32x4*)dst = o0; *(u32x4*)(dst + 8) = o1; }
    }
}

__device__ __forceinline__ void phase_cnorm(const Frame& F, const Params& p) {
    const bf16_t* MID = (const bf16_t*)(F.ws + WS_MID); bf16_t* C = (bf16_t*)(F.ws + WS_C);
    const float g0 = INP(3)[2 * F.lane], g1 = INP(3)[2 * F.lane + 1];
    for (int m0 = F.gw * 8; m0 < MTOK; m0 += F.NGW * 8) {
        unsigned wv_[8]; float ss[8];
#pragma unroll
        for (int u = 0; u < 8; ++u) wv_[u] = *(const unsigned*)(MID + (size_t)(m0 + u) * 512 + 2 * F.lane);
#pragma unroll
        for (int u = 0; u < 8; ++u) { const float a = bflo(wv_[u]), b = bfhi(wv_[u]); ss[u] = a * a + b * b; }
#pragma unroll
        for (int o = 1; o < 64; o <<= 1) {
#pragma unroll
            for (int u = 0; u < 8; ++u) ss[u] += __shfl_xor(ss[u], o); }
#pragma unroll
        for (int u = 0; u < 8; ++u) { const float rstd = 1.0f / sqrtf(ss[u] * (1.0f / 128.0f) + EPS);
            *(unsigned*)(C + (size_t)(m0 + u) * 128 + 2 * F.lane) = cvt_pk_bf16(bflo(wv_[u]) * rstd * g0, bfhi(wv_[u]) * rstd * g1); }
    }
}

__device__ __forceinline__ float relu_i(float x) { return __int_as_float(max(__float_as_int(x), 0)); }
__device__ __forceinline__ unsigned f2key(float f) { const unsigned u = __float_as_uint(f + 0.0f);     return u ^ ((unsigned)((int)u >> 31) | 0x80000000u); }
__device__ __forceinline__ float key2f(unsigned k) { return __uint_as_float((k & 0x80000000u) ? (k ^ 0x80000000u) : ~k); }
__device__ __forceinline__ void find_thr(const LAS unsigned* hrow, int rot8, unsigned need, int lane, unsigned& bin, unsigned& above) {
    const int pl = lane; (void)rot8;
    const u32x4 w0 = *(const LAS u32x4*)(hrow + 8 * pl), w1 = *(const LAS u32x4*)(hrow + 8 * pl + 4);
    unsigned w[8] = {w0.x, w0.y, w0.z, w0.w, w1.x, w1.y, w1.z, w1.w};
    unsigned ls = 0;
#pragma unroll
    for (int k = 0; k < 8; ++k) ls += (w[k] & 0xffffu) + (w[k] >> 16);
    unsigned incl = ls;
#pragma unroll
    for (int off = 1; off < 64; off <<= 1) { const unsigned v = __shfl_down(incl, off); if (lane + off < 64) incl += v; }
    const unsigned excl = incl - ls;
    const bool hit = excl < need && incl >= need;
    const unsigned long long mk = __ballot(hit);
    const int src = mk ? (__ffsll((long long)mk) - 1) : 0;
    unsigned cum = excl, b = 16 * lane, ab = excl; bool found = false;
#pragma unroll
    for (int k = 7; k >= 0; --k) {
        unsigned c = w[k] >> 16; if (!found && cum + c >= need) { b = 16 * lane + 2 * k + 1; ab = cum; found = true; } cum += c;
        c = w[k] & 0xffffu;      if (!found && cum + c >= need) { b = 16 * lane + 2 * k; ab = cum; found = true; } cum += c;
    }
    bin = mk ? __shfl(b, src) : 0u; above = __shfl(ab, src);
}

template <int N>
__device__ __forceinline__ void find_thr_n(const LAS unsigned* hrow0, int q0, const unsigned (&need)[N], int lane, unsigned (&bin)[N], unsigned (&above)[N]) {
    unsigned w[N][8], ls[N], incl[N];
#pragma unroll
    for (int i = 0; i < N; ++i) { const int pl = lane; (void)q0; const LAS unsigned* hr = hrow0 + i * 512;
        const u32x4 w0 = *(const LAS u32x4*)(hr + 8 * pl), w1 = *(const LAS u32x4*)(hr + 8 * pl + 4);
        w[i][0] = w0.x; w[i][1] = w0.y; w[i][2] = w0.z; w[i][3] = w0.w; w[i][4] = w1.x; w[i][5] = w1.y; w[i][6] = w1.z; w[i][7] = w1.w; }
#pragma unroll
    for (int i = 0; i < N; ++i) { unsigned t = 0;
#pragma unroll
        for (int k = 0; k < 8; ++k) t += (w[i][k] & 0xffffu) + (w[i][k] >> 16);
        ls[i] = t; incl[i] = t; }
#pragma unroll
    for (int off = 1; off < 64; off <<= 1) {
#pragma unroll
        for (int i = 0; i < N; ++i) { const unsigned v = __shfl_down(incl[i], off); if (lane + off < 64) incl[i] += v; } }
    unsigned b[N], ab[N]; int src[N]; unsigned long long mk[N];
#pragma unroll
    for (int i = 0; i < N; ++i) { const unsigned excl = incl[i] - ls[i]; mk[i] = __ballot(excl < need[i] && incl[i] >= need[i]); src[i] = mk[i] ? (__ffsll((long long)mk[i]) - 1) : 0;
        unsigned cum = excl; b[i] = 16 * lane; ab[i] = excl; bool found = false;
#pragma unroll
        for (int k = 7; k >= 0; --k) {
            unsigned c = w[i][k] >> 16; if (!found && cum + c >= need[i]) { b[i] = 16 * lane + 2 * k + 1; ab[i] = cum; found = true; } cum += c;
            c = w[i][k] & 0xffffu;      if (!found && cum + c >= need[i]) { b[i] = 16 * lane + 2 * k; ab[i] = cum; found = true; } cum += c; } }
#pragma unroll
    for (int i = 0; i < N; ++i) { bin[i] = mk[i] ? __shfl(b[i], src[i]) : 0u; above[i] = __shfl(ab[i], src[i]); }
}
#define TKT0()
#define TKT0R()
#define TKT1(i)
__device__ __forceinline__ void topk_unit_ref(const Frame& F, int b, int ch, unsigned short* IDX) {
    const bf16_t* MID = (const bf16_t*)(F.ws + WS_MID);
    const int lane = F.lane, w = F.wave, r = lane & 31, hi = lane >> 5;
    const int limit = 64 * (ch + 1), tok0 = b * SEQ + 64 * ch;
    LAS unsigned* hist = (LAS unsigned*)(F.lds + w * 16384);
    LAS unsigned short* outl = (LAS unsigned short*)hist;
    if (limit <= 256) {
#pragma unroll
        for (int qq = 0; qq < 8; ++qq) { const int tok = tok0 + 8 * w + qq; u32x2 o; o.x = (4u * lane) | ((4u * lane + 1u) << 16); o.y = (4u * lane + 2u) | ((4u * lane + 3u) << 16);
            *(u32x2*)(IDX + (size_t)tok * 256 + 4 * lane) = o; }
        return;
    }
    bf16x8 a[4];
    { const bf16_t* ap = MID + (size_t)(tok0 + 8 * w + (r >> 2)) * 512 + 128 + (r & 3) * 64 + 8 * hi;
#pragma unroll
      for (int s = 0; s < 4; ++s) a[s] = *(const bf16x8*)(ap + 16 * s); }
    float wv[4][4];
#pragma unroll
    for (int g = 0; g < 4; ++g) { const u32x2 ww = *(const u32x2*)(MID + (size_t)(tok0 + 8 * w + 2 * g + hi) * 512 + 448);
        wv[g][0] = bflo(ww.x) * 0.0625f; wv[g][1] = bfhi(ww.x) * 0.0625f; wv[g][2] = bflo(ww.y) * 0.0625f; wv[g][3] = bfhi(ww.y) * 0.0625f; }
    asm volatile("" :: "v"(a[0]), "v"(a[1]), "v"(a[2]), "v"(a[3]));
    asm volatile("" :: "v"(wv[0][0]), "v"(wv[0][1]), "v"(wv[0][2]), "v"(wv[0][3]), "v"(wv[1][0]), "v"(wv[1][1]), "v"(wv[1][2]), "v"(wv[1][3]),
                       "v"(wv[2][0]), "v"(wv[2][1]), "v"(wv[2][2]), "v"(wv[2][3]), "v"(wv[3][0]), "v"(wv[3][1]), "v"(wv[3][2]), "v"(wv[3][3]));
    unsigned b1[4], ab1[4], Gc[4], Ec[4], cgt[4], ceq[4]; float thA[4], thB[4];
#pragma unroll
    for (int g = 0; g < 4; ++g) { b1[g] = 0; ab1[g] = 0; Gc[g] = 0; Ec[g] = 0; cgt[g] = 0; ceq[g] = 0; thA[g] = -INFINITY; thB[g] = 0.f; }
    const int npair = ch + 1;
    LAS unsigned char* ktl = F.lds + LDS_GEMM + LDS_MISC;
    const bf16_t* gsrc = MID + (size_t)(b * SEQ + (F.tid >> 3)) * 512 + 384 + (F.tid & 7) * 8;
    const unsigned swoff = (unsigned)(F.tid >> 3) * 144u + (unsigned)(F.tid & 7) * 16u, rdoff = (unsigned)r * 144u + (unsigned)hi * 16u;
    const unsigned lm = (1u << r) - 1u;
    const unsigned dummyw = (unsigned)(LDS_GEMM / 4 + w * 64 + lane) - (unsigned)(w * 4096);
    auto run_pass = [&](auto PT_) __attribute__((always_inline)) {
        constexpr int pass = decltype(PT_)::value;
        if (pass < 2) {
#pragma unroll
            for (int i = 0; i < 16; ++i) *(LAS u32x4*)(hist + 4 * lane + 256 * i) = (u32x4){0u, 0u, 0u, 0u};
        }
        LDS_WAIT();
#define KT_PTR(T) (gsrc + (size_t)((T) < npair ? (T) : npair - 1) * 64 * 512)
#define KT_ISSUE(DST, T) asm volatile("global_load_dwordx4 %0, %1, off" : "=v"(DST) : "v"(KT_PTR(T)) : "memory")
#define KT_WAIT(DST, N) asm volatile("s_waitcnt vmcnt(" #N ")" : "+v"(DST) :: "memory")
#define TK_SCORE4(AC, KT) do { float sc[4]; \
        _Pragma("unroll") for (int g = 0; g < 4; ++g) { \
            const float r0 = relu_i(AC[4 * g]), r1 = relu_i(AC[4 * g + 1]), r2 = relu_i(AC[4 * g + 2]), r3 = relu_i(AC[4 * g + 3]); \
            sc[g] = __fmaf_rn(wv[g][3], r3, __fmaf_rn(wv[g][2], r2, __fmaf_rn(wv[g][1], r1, __fmul_rn(wv[g][0], r0)))); } \
        if (pass < 2) {     \
            unsigned wa[4], inc[4]; \
            _Pragma("unroll") for (int g = 0; g < 4; ++g) { \
                const bool c = pass == 0 ? (sc[g] >= thA[g]) : ((sc[g] >= thA[g]) & (sc[g] < thB[g])); \
                const unsigned key = f2key(sc[g]), bin = pass == 0 ? (key >> 22) : ((key >> 12) & 1023u); \
                const unsigned real = (unsigned)(2 * g + hi) * 512u + (bin >> 1); \
                wa[g] = c ? real : dummyw; inc[g] = c ? (1u << (16 * (bin & 1u))) : 0u; } \
            _Pragma("unroll") for (int g = 0; g < 4; ++g) (void)__hip_atomic_fetch_add(hist + wa[g], inc[g], __ATOMIC_RELAXED, __HIP_MEMORY_SCOPE_WORKGROUP); \
        } else {     \
            unsigned long long mge[4], mgt[4]; unsigned long long anyeq = 0ull; bool gtb[4]; \
            _Pragma("unroll") for (int g = 0; g < 4; ++g) { gtb[g] = sc[g] >= thB[g]; mge[g] = __ballot(sc[g] >= thA[g]); mgt[g] = __ballot(gtb[g]); anyeq |= mge[g] & ~mgt[g]; } \
            const unsigned short kidx = (unsigned short)((KT) * 32 + r); \
            unsigned pos[4]; \
            _Pragma("unroll") for (int g = 0; g < 4; ++g) { const unsigned myg = hi ? (unsigned)(mgt[g] >> 32) : (unsigned)mgt[g]; pos[g] = cgt[g] + __popc(myg & lm); cgt[g] += __popc(myg); } \
            _Pragma("unroll") for (int g = 0; g < 4; ++g) if (gtb[g] & (pos[g] < 256u)) outl[(2 * g + hi) * 256 + pos[g]] = kidx; \
            if (anyeq) { \
                _Pragma("unroll") for (int g = 0; g < 4; ++g) { const unsigned long long me = mge[g] & ~mgt[g]; \
                    if (me) { const unsigned mye = hi ? (unsigned)(me >> 32) : (unsigned)me; const bool eq = (sc[g] >= thA[g]) & !gtb[g]; \
                        if (eq) { const unsigned rk = ceq[g] + __popc(mye & lm); if (rk < Ec[g]) { const unsigned ps = Gc[g] + rk; if (ps < 256u) outl[(2 * g + hi) * 256 + ps] = kidx; } } \
                        ceq[g] += __popc(mye); } } } } } while (0)
#define TK_LB(J) do { if (pass == 0 && ((J) == 7 || (J) == 31) && (J) + 1 < npair) { LDS_WAIT(); \
        _Pragma("unroll") for (int qq = 0; qq < 8; ++qq) { unsigned bin, above; find_thr(hist + qq * 512, qq >> 1, 256u, lane, bin, above); if ((qq & 1) == hi && bin >= 2u) thA[qq >> 1] = key2f(bin << 22); } } } while (0)
        u32x4 g0, g1, gqA, gqB, gqC, gqD;
        KT_ISSUE(g0, 0); KT_ISSUE(g1, 1); KT_ISSUE(gqA, 2); KT_ISSUE(gqB, 3); KT_ISSUE(gqC, 4); KT_ISSUE(gqD, 5);
        asm volatile("s_waitcnt vmcnt(4)" : "+v"(g0), "+v"(g1) :: "memory");
        *(LAS u32x4*)(ktl + swoff) = g0; *(LAS u32x4*)(ktl + 9216 + swoff) = g1;
        __syncthreads();
        bf16x8 bkX[4], bkY[4];
#pragma unroll
        for (int s = 0; s < 4; ++s) { bkX[s] = *(const LAS bf16x8*)(ktl + rdoff + s * 32); bkY[s] = bkX[s]; }
        f32x16 accX, accY;
#pragma unroll
        for (int i = 0; i < 16; ++i) { accX[i] = 0.f; accY[i] = 0.f; }
        int bc = 0, bn = 1, bs = 2;
#define TK_STEP(BKC, BKN, ACCC, ACCP, KT, NXP) { \
            _Pragma("unroll") for (int i = 0; i < 16; ++i) ACCC[i] = 0.f; \
            _Pragma("unroll") for (int s = 0; s < 4; ++s) ACCC = __builtin_amdgcn_mfma_f32_32x32x16_bf16(a[s], BKC[s], ACCC, 0, 0, 0); \
            _Pragma("unroll") for (int s = 0; s < 4; ++s) BKN[s] = *(const LAS bf16x8*)((NXP) + s * 32); \
            if ((KT) > 0) TK_SCORE4(ACCP, (KT) - 1); }
#define TK_ROUND(GQ) { \
            TK_STEP(bkX, bkY, accX, accY, 2 * it, ktl + bc * 9216 + rdoff + 32 * 144) \
            if (it > 0) TK_LB(it - 1); \
            TK_STEP(bkY, bkX, accY, accX, 2 * it + 1, ktl + bn * 9216 + rdoff) \
            KT_WAIT(GQ, 3); \
            *(LAS u32x4*)(ktl + bs * 9216 + swoff) = GQ; \
            KT_ISSUE(GQ, it + 6); \
            { const int t_ = bc; bc = bn; bn = bs; bs = t_; } \
            __syncthreads(); }
#pragma unroll 1
        for (int it0 = 0; it0 < npair; it0 += 4) {
            { const int it = it0;     if (it < npair) TK_ROUND(gqA) }
            { const int it = it0 + 1; if (it < npair) TK_ROUND(gqB) }
            { const int it = it0 + 2; if (it < npair) TK_ROUND(gqC) }
            { const int it = it0 + 3; if (it < npair) TK_ROUND(gqD) }
        }
        asm volatile("s_waitcnt vmcnt(0)" : "+v"(gqA), "+v"(gqB), "+v"(gqC), "+v"(gqD) :: "memory");
        TK_SCORE4(accY, 2 * npair - 1);
        TKT1(40 + pass);
#undef TK_STEP
#undef TK_SCORE4
#undef TK_ROUND
#undef TK_LB
#undef KT_PTR
#undef KT_ISSUE
#undef KT_WAIT
        LDS_WAIT();
        TKT0R();
        if (pass == 0) {
#pragma unroll
            for (int h4 = 0; h4 < 2; ++h4) { const unsigned nd[4] = {256u, 256u, 256u, 256u}; unsigned bn4[4], ab4[4]; find_thr_n<4>(hist + h4 * 4 * 512, h4 * 4, nd, lane, bn4, ab4);
#pragma unroll
                for (int i = 0; i < 4; ++i) { const int qq = h4 * 4 + i; if ((qq & 1) == hi) { b1[qq >> 1] = bn4[i]; ab1[qq >> 1] = ab4[i]; thA[qq >> 1] = key2f(bn4[i] << 22); thB[qq >> 1] = key2f((bn4[i] + 1u) << 22); } } }
        } else if (pass == 1) {
#pragma unroll
            for (int h4 = 0; h4 < 2; ++h4) { unsigned nd[4], bn4[4], ab4[4];
#pragma unroll
                for (int i = 0; i < 4; ++i) { const int qq = h4 * 4 + i; nd[i] = 256u - __shfl(ab1[qq >> 1], (qq & 1) * 32); }
                find_thr_n<4>(hist + h4 * 4 * 512, h4 * 4, nd, lane, bn4, ab4);
#pragma unroll
                for (int i = 0; i < 4; ++i) { const int qq = h4 * 4 + i; if ((qq & 1) == hi) { const unsigned t20 = (b1[qq >> 1] << 10) | bn4[i]; thA[qq >> 1] = key2f(t20 << 12); thB[qq >> 1] = key2f((t20 + 1u) << 12); Gc[qq >> 1] = ab1[qq >> 1] + ab4[i]; Ec[qq >> 1] = 256u - (ab1[qq >> 1] + ab4[i]); } } }
        }
        LDS_WAIT();
        TKT1(43);
    };
    run_pass(std::integral_constant<int, 0>{}); run_pass(std::integral_constant<int, 1>{}); run_pass(std::integral_constant<int, 2>{});
#pragma unroll
    for (int qq = 0; qq < 8; ++qq) { const int tok = tok0 + 8 * w + qq;
        if (lane < 32) *(u32x4*)(IDX + (size_t)tok * 256 + lane * 8) = *(const LAS u32x4*)(outl + qq * 256 + lane * 8); }
    LDS_WAIT();
}
__device__ __forceinline__ int tk_bin(float s, int ebase) {
    const unsigned u = __float_as_uint(s + 0.0f); const int c = (int)((u & 0x7fffffffu) >> 18), sg = (int)u >> 31;
    const int d = c - ebase;
    const int t = 32 - ((ebase + 39 - c) >> 3);
    const int cc = max(max(d, t), 0);
    return min(max(512 + (cc ^ sg), 0), 1023);
}
__device__ __forceinline__ float tk_edge(int b, int ebase) {
    if (b <= 0) return -INFINITY;
    if (b >= 1024) return INFINITY;
    if (b >= 513) { const int m = b - 512; const int c = m >= 33 ? m + ebase : ebase + 40 - ((33 - m) << 3); return c <= 0 ? 0.0f : (c >= (255 << 5) ? INFINITY : __uint_as_float((unsigned)c << 18)); }
    if (b == 512) return 0.0f;
    { const int m = 512 - b; const int c = m >= 33 ? m + ebase : ebase + 40 - ((33 - m) << 3);
      if (c <= 0) return -0.0f; if (c >= (255 << 5)) return -INFINITY;
      return __uint_as_float((0x80000000u | ((unsigned)c << 18)) - 1u); }
}
template <int N>
__device__ __forceinline__ void find_thr_c(const LAS unsigned* hrow0, const unsigned (&need)[N], int lane, unsigned (&bin)[N], unsigned (&above)[N], unsigned (&cntb)[N]) {
    unsigned w[N][8], ls[N], incl[N];
#pragma unroll
    for (int i = 0; i < N; ++i) { const LAS unsigned* hr = hrow0 + i * 512;
        const u32x4 w0 = *(const LAS u32x4*)(hr + 8 * lane), w1 = *(const LAS u32x4*)(hr + 8 * lane + 4);
        w[i][0] = w0.x; w[i][1] = w0.y; w[i][2] = w0.z; w[i][3] = w0.w; w[i][4] = w1.x; w[i][5] = w1.y; w[i][6] = w1.z; w[i][7] = w1.w; }
#pragma unroll
    for (int i = 0; i < N; ++i) { unsigned t = 0;
#pragma unroll
        for (int k = 0; k < 8; ++k) t += (w[i][k] & 0xffffu) + (w[i][k] >> 16);
        ls[i] = t; incl[i] = t; }
#pragma unroll
    for (int off = 1; off < 64; off <<= 1) {
#pragma unroll
        for (int i = 0; i < N; ++i) { const unsigned v = __shfl_down(incl[i], off); if (lane + off < 64) incl[i] += v; } }
    unsigned bb[N], ab[N], cb[N]; int src[N]; unsigned long long mk[N];
#pragma unroll
    for (int i = 0; i < N; ++i) { const unsigned excl = incl[i] - ls[i]; mk[i] = __ballot(excl < need[i] && incl[i] >= need[i]); src[i] = mk[i] ? (__ffsll((long long)mk[i]) - 1) : 0;
        unsigned cum = excl; bb[i] = 16 * lane; ab[i] = excl; cb[i] = 0; bool found = false;
#pragma unroll
        for (int k = 7; k >= 0; --k) {
            unsigned c = w[i][k] >> 16; if (!found && cum + c >= need[i]) { bb[i] = 16 * lane + 2 * k + 1; ab[i] = cum; cb[i] = c; found = true; } cum += c;
            c = w[i][k] & 0xffffu;      if (!found && cum + c >= need[i]) { bb[i] = 16 * lane + 2 * k; ab[i] = cum; cb[i] = c; found = true; } cum += c; } }
#pragma unroll
    for (int i = 0; i < N; ++i) { bin[i] = mk[i] ? __shfl(bb[i], src[i]) : 0u; above[i] = __shfl(ab[i], src[i]); cntb[i] = __shfl(cb[i], src[i]); }
}
__device__ __forceinline__ void topk_unit(const Frame& F, int b, int ch) {
    const bf16_t* MID = (const bf16_t*)(F.ws + WS_MID); unsigned short* IDX = (unsigned short*)(F.ws + WS_IDX);
    const int lane = F.lane, w = F.wave, r = lane & 31, hi = lane >> 5;
    const int limit = 64 * (ch + 1), tok0 = b * SEQ + 64 * ch;
    LAS unsigned* hist = (LAS unsigned*)(F.lds + w * 16384);
    LAS unsigned short* outl = (LAS unsigned short*)hist;
    if (limit <= 256) {
#pragma unroll
        for (int qq = 0; qq < 8; ++qq) { const int tok = tok0 + 8 * w + qq; u32x2 o; o.x = (4u * lane) | ((4u * lane + 1u) << 16); o.y = (4u * lane + 2u) | ((4u * lane + 3u) << 16);
            *(u32x2*)(IDX + (size_t)tok * 256 + 4 * lane) = o; }
        return;
    }
    bf16x8 a[4];
    { const bf16_t* ap = MID + (size_t)(tok0 + 8 * w + (r >> 2)) * 512 + 128 + (r & 3) * 64 + 8 * hi;
#pragma unroll
      for (int s = 0; s < 4; ++s) a[s] = *(const bf16x8*)(ap + 16 * s); }
    float wv[4][4];
#pragma unroll
    for (int g = 0; g < 4; ++g) { const u32x2 ww = *(const u32x2*)(MID + (size_t)(tok0 + 8 * w + 2 * g + hi) * 512 + 448);
        wv[g][0] = bflo(ww.x) * 0.0625f; wv[g][1] = bfhi(ww.x) * 0.0625f; wv[g][2] = bflo(ww.y) * 0.0625f; wv[g][3] = bfhi(ww.y) * 0.0625f; }
    asm volatile("" :: "v"(a[0]), "v"(a[1]), "v"(a[2]), "v"(a[3]));
    asm volatile("" :: "v"(wv[0][0]), "v"(wv[0][1]), "v"(wv[0][2]), "v"(wv[0][3]), "v"(wv[1][0]), "v"(wv[1][1]), "v"(wv[1][2]), "v"(wv[1][3]),
                       "v"(wv[2][0]), "v"(wv[2][1]), "v"(wv[2][2]), "v"(wv[2][3]), "v"(wv[3][0]), "v"(wv[3][1]), "v"(wv[3][2]), "v"(wv[3][3]));
    int ecode[4], bT[4], lbb[4]; unsigned Gc[4], Ec[4], cgt[4], ceq[4]; bool lst[4]; float mxa[4]; float eLo[4] = {0.f, 0.f, 0.f, 0.f}, eHi[4] = {0.f, 0.f, 0.f, 0.f}; float vmin[4] = {3e38f, 3e38f, 3e38f, 3e38f}, vmax[4] = {-3e38f, -3e38f, -3e38f, -3e38f}, tmn[4] = {0.f, 0.f, 0.f, 0.f}; int tsel[4] = {-1, -1, -1, -1}, tuns[4] = {1 << 30, 1 << 30, 1 << 30, 1 << 30};
#pragma unroll
    for (int g = 0; g < 4; ++g) { ecode[g] = 0; bT[g] = 0; lbb[g] = 0; Gc[g] = 0; Ec[g] = 0; cgt[g] = 0; ceq[g] = 0; lst[g] = false; mxa[g] = 0.f; }
    const int npair = ch + 1;
    LAS unsigned char* ktl = F.lds + LDS_GEMM + LDS_MISC;
    const bf16_t* gsrc = MID + (size_t)(b * SEQ + (F.tid >> 3)) * 512 + 384 + (F.tid & 7) * 8;
    const unsigned swoff = (unsigned)(F.tid >> 3) * 144u + (unsigned)(F.tid & 7) * 16u, rdoff = (unsigned)r * 144u + (unsigned)hi * 16u;
    const unsigned lm = (1u << r) - 1u;
    const unsigned dummyw = (unsigned)(LDS_GEMM / 4 + w * 64 + lane) - (unsigned)(w * 4096);
    auto run_pass = [&](auto PT_) __attribute__((always_inline)) {
        constexpr int pass = decltype(PT_)::value;
        const int nr = pass < 0 ? (npair < 4 ? npair : 4) : npair;
        if (pass == 0) {
#pragma unroll
            for (int i = 0; i < 16; ++i) *(LAS u32x4*)(hist + 4 * lane + 256 * i) = (u32x4){0u, 0u, 0u, 0u};
        }
        LDS_WAIT();
#define KT_PTR(T) (gsrc + (size_t)((T) < npair ? (T) : npair - 1) * 64 * 512)
#define KT_ISSUE(DST, T) asm volatile("global_load_dwordx4 %0, %1, off" : "=v"(DST) : "v"(KT_PTR(T)) : "memory")
#define KT_WAIT(DST, N) asm volatile("s_waitcnt vmcnt(" #N ")" : "+v"(DST) :: "memory")
#define TK_SCORE4(AC, KT) do { float sc[4]; \
        _Pragma("unroll") for (int g = 0; g < 4; ++g) { \
            const float r0 = relu_i(AC[4 * g]), r1 = relu_i(AC[4 * g + 1]), r2 = relu_i(AC[4 * g + 2]), r3 = relu_i(AC[4 * g + 3]); \
            sc[g] = __fmaf_rn(wv[g][3], r3, __fmaf_rn(wv[g][2], r2, __fmaf_rn(wv[g][1], r1, __fmul_rn(wv[g][0], r0)))); } \
        if (pass < 0) { \
            _Pragma("unroll") for (int g = 0; g < 4; ++g) mxa[g] = fmaxf(mxa[g], __builtin_fabsf(sc[g])); \
        } else if (pass == 3) {     \
            const unsigned ix_ = (unsigned)(KT) * 32u + (unsigned)r; \
            _Pragma("unroll") for (int g = 0; g < 4; ++g) { const bool sel_ = (hist[(2 * g + hi) * 512 + 256 + (ix_ >> 5)] >> (ix_ & 31u)) & 1u; \
                vmin[g] = sel_ ? fminf(vmin[g], sc[g]) : vmin[g]; vmax[g] = sel_ ? vmax[g] : fmaxf(vmax[g], sc[g]); } \
        } else if (pass == 4) {     \
            const unsigned ix_ = (unsigned)(KT) * 32u + (unsigned)r; \
            _Pragma("unroll") for (int g = 0; g < 4; ++g) { const bool sel_ = (hist[(2 * g + hi) * 512 + 256 + (ix_ >> 5)] >> (ix_ & 31u)) & 1u; \
                if (sc[g] == tmn[g]) { if (sel_) tsel[g] = max(tsel[g], (int)ix_); else tuns[g] = min(tuns[g], (int)ix_); } } \
        } else if (pass == 0) {     \
            unsigned wa[4], inc[4]; \
            _Pragma("unroll") for (int g = 0; g < 4; ++g) { const int bin = tk_bin(sc[g], ecode[g]); const bool c = bin >= lbb[g]; \
                wa[g] = c ? ((unsigned)(2 * g + hi) * 512u + ((unsigned)bin >> 1)) : dummyw; inc[g] = c ? (1u << (16 * (bin & 1))) : 0u; } \
            _Pragma("unroll") for (int g = 0; g < 4; ++g) (void)__hip_atomic_fetch_add(hist + wa[g], inc[g], __ATOMIC_RELAXED, __HIP_MEMORY_SCOPE_WORKGROUP); \
        } else {     \
            unsigned long long mge[4], mgt[4]; unsigned long long anyeq = 0ull; bool gtb[4], eqb[4]; \
            _Pragma("unroll") for (int g = 0; g < 4; ++g) { gtb[g] = sc[g] >= eHi[g]; eqb[g] = (sc[g] >= eLo[g]) & !gtb[g]; mgt[g] = __ballot(gtb[g]); mge[g] = __ballot(eqb[g]); anyeq |= mge[g]; } \
            const unsigned short kidx = (unsigned short)((KT) * 32 + r); \
            unsigned pos[4]; \
            _Pragma("unroll") for (int g = 0; g < 4; ++g) { const unsigned myg = hi ? (unsigned)(mgt[g] >> 32) : (unsigned)mgt[g]; pos[g] = cgt[g] + __popc(myg & lm); cgt[g] += __popc(myg); } \
            _Pragma("unroll") for (int g = 0; g < 4; ++g) if (gtb[g] & (pos[g] < 256u)) outl[(2 * g + hi) * 1024 + pos[g]] = kidx; \
            if (anyeq) { \
                _Pragma("unroll") for (int g = 0; g < 4; ++g) if (mge[g]) { const unsigned mye = hi ? (unsigned)(mge[g] >> 32) : (unsigned)mge[g]; const int q = 2 * g + hi; \
                    if (eqb[g]) { const unsigned rk = ceq[g] + __popc(mye & lm); \
                        if (lst[g]) { if (rk < 128u) { outl[q * 1024 + 256 + rk] = kidx; hist[q * 512 + 256 + rk] = f2key(sc[g]); } } \
                        else if (rk < Ec[g]) { const unsigned ps = Gc[g] + rk; if (ps < 256u) outl[q * 1024 + ps] = kidx; } } \
                    ceq[g] += __popc(mye); } } } } while (0)
#define TK_LB(J) do { if (pass == 0 && ((J) == 7 || (J) == 31) && (J) + 1 < npair) { LDS_WAIT(); \
        _Pragma("unroll") for (int h4 = 0; h4 < 2; ++h4) { const unsigned nd[4] = {256u, 256u, 256u, 256u}; unsigned bn4[4], ab4[4], cb4[4]; find_thr_c<4>(hist + h4 * 4 * 512, nd, lane, bn4, ab4, cb4); \
            _Pragma("unroll") for (int i = 0; i < 4; ++i) { const int qq = h4 * 4 + i; if ((qq & 1) == hi && bn4[i] >= 1u) lbb[qq >> 1] = (int)bn4[i]; } } } } while (0)
        u32x4 g0, g1, gqA, gqB, gqC, gqD;
        KT_ISSUE(g0, 0); KT_ISSUE(g1, 1); KT_ISSUE(gqA, 2); KT_ISSUE(gqB, 3); KT_ISSUE(gqC, 4); KT_ISSUE(gqD, 5);
        asm volatile("s_waitcnt vmcnt(4)" : "+v"(g0), "+v"(g1) :: "memory");
        *(LAS u32x4*)(ktl + swoff) = g0; *(LAS u32x4*)(ktl + 9216 + swoff) = g1;
        __syncthreads();
        bf16x8 bkX[4], bkY[4];
#pragma unroll
        for (int s = 0; s < 4; ++s) { bkX[s] = *(const LAS bf16x8*)(ktl + rdoff + s * 32); bkY[s] = bkX[s]; }
        f32x16 accX, accY;
#pragma unroll
        for (int i = 0; i < 16; ++i) { accX[i] = 0.f; accY[i] = 0.f; }
        int bc = 0, bn = 1, bs = 2;
#define TK_STEP(BKC, BKN, ACCC, ACCP, KT, NXP) { \
            _Pragma("unroll") for (int i = 0; i < 16; ++i) ACCC[i] = 0.f; \
            _Pragma("unroll") for (int s = 0; s < 4; ++s) ACCC = __builtin_amdgcn_mfma_f32_32x32x16_bf16(a[s], BKC[s], ACCC, 0, 0, 0); \
            _Pragma("unroll") for (int s = 0; s < 4; ++s) BKN[s] = *(const LAS bf16x8*)((NXP) + s * 32); \
            if ((KT) > 0) TK_SCORE4(ACCP, (KT) - 1); }
#define TK_ROUND(GQ) { \
            TK_STEP(bkX, bkY, accX, accY, 2 * it, ktl + bc * 9216 + rdoff + 32 * 144) \
            if (it > 0) TK_LB(it - 1); \
            TK_STEP(bkY, bkX, accY, accX, 2 * it + 1, ktl + bn * 9216 + rdoff) \
            KT_WAIT(GQ, 3); \
            *(LAS u32x4*)(ktl + bs * 9216 + swoff) = GQ; \
            KT_ISSUE(GQ, it + 6); \
            { const int t_ = bc; bc = bn; bn = bs; bs = t_; } \
            __syncthreads(); }
#pragma unroll 1
        for (int it0 = 0; it0 < nr; it0 += 4) {
            { const int it = it0;     if (it < nr) TK_ROUND(gqA) }
            { const int it = it0 + 1; if (it < nr) TK_ROUND(gqB) }
            { const int it = it0 + 2; if (it < nr) TK_ROUND(gqC) }
            { const int it = it0 + 3; if (it < nr) TK_ROUND(gqD) }
        }
        asm volatile("s_waitcnt vmcnt(0)" : "+v"(gqA), "+v"(gqB), "+v"(gqC), "+v"(gqD) :: "memory");
        TK_SCORE4(accY, 2 * nr - 1);
#undef TK_STEP
#undef TK_SCORE4
#undef TK_ROUND
#undef TK_LB
#undef KT_PTR
#undef KT_ISSUE
#undef KT_WAIT
        LDS_WAIT();
        if (pass < 0) {
#pragma unroll
            for (int g = 0; g < 4; ++g) { float v = mxa[g];
#pragma unroll
                for (int o = 1; o < 32; o <<= 1) v = fmaxf(v, __shfl_xor(v, o));
                const int eS = (int)((__float_as_uint(v) >> 23) & 0xffu), e0 = max(eS - 13, 2); ecode[g] = (e0 << 5) - 32; }
        } else if (pass == 0) {
#pragma unroll
            for (int h4 = 0; h4 < 2; ++h4) { const unsigned nd[4] = {256u, 256u, 256u, 256u}; unsigned bn4[4], ab4[4], cb4[4]; find_thr_c<4>(hist + h4 * 4 * 512, nd, lane, bn4, ab4, cb4);
#pragma unroll
                for (int i = 0; i < 4; ++i) { const int qq = h4 * 4 + i; if ((qq & 1) == hi) { bT[qq >> 1] = (int)bn4[i]; Gc[qq >> 1] = ab4[i]; Ec[qq >> 1] = 256u - ab4[i]; lst[qq >> 1] = cb4[i] <= 128u;
                    eLo[qq >> 1] = tk_edge((int)bn4[i], ecode[qq >> 1]); eHi[qq >> 1] = tk_edge((int)bn4[i] + 1, ecode[qq >> 1]); } } }
        } else if (pass == 2) {
#pragma unroll 1
            for (int qq = 0; qq < 8; ++qq) { const int g = qq >> 1, sl = (qq & 1) * 32;
                const unsigned nl = min(__shfl(ceq[g], sl), 128u), E = __shfl(Ec[g], sl), G = __shfl(Gc[g], sl); const bool lm_ = __shfl((int)lst[g], sl) != 0;
                if (lm_ && nl > 0u) {
                    const LAS unsigned* lk = hist + qq * 512 + 256; const LAS unsigned short* li = outl + qq * 1024 + 256;
                    const unsigned k0 = (unsigned)lane < nl ? lk[lane] : 0u, k1 = (unsigned)lane + 64u < nl ? lk[lane + 64] : 0u;
                    const unsigned i0 = (unsigned)lane < nl ? li[lane] : 0u, i1 = (unsigned)lane + 64u < nl ? li[lane + 64] : 0u;
                    unsigned r0 = 0u, r1 = 0u;
#pragma unroll 1
                    for (unsigned j = 0; j < nl; ++j) { const unsigned kj = lk[j], ij = li[j];
                        r0 += (kj > k0) | ((kj == k0) & (ij < i0)); r1 += (kj > k1) | ((kj == k1) & (ij < i1)); }
                    if ((unsigned)lane < nl && r0 < E && G + r0 < 256u) outl[qq * 1024 + G + r0] = (unsigned short)i0;
                    if ((unsigned)lane + 64u < nl && r1 < E && G + r1 < 256u) outl[qq * 1024 + G + r1] = (unsigned short)i1;
                } }
        }
        LDS_WAIT();
    };
#ifdef TK_VALIDATE_OLD
    run_pass(std::integral_constant<int, -1>{});
#else
    run_pass(std::integral_constant<int, -1>{}); run_pass(std::integral_constant<int, 0>{}); run_pass(std::integral_constant<int, 2>{});
#endif
#ifdef TK_VALIDATE
    {
#ifdef TK_VALIDATE_OLD
        asm volatile("s_waitcnt vmcnt(0)" ::: "memory");
#pragma unroll 1
        for (int qq = 0; qq < 8; ++qq) for (int i = 0; i < 4; ++i) outl[qq * 1024 + lane * 4 + i] = __hip_atomic_load(IDX + (size_t)(tok0 + 8 * w + qq) * 256 + lane * 4 + i, __ATOMIC_RELAXED, __HIP_MEMORY_SCOPE_AGENT);
        LDS_WAIT();
#endif
#pragma unroll 1
        for (int qq = 0; qq < 8; ++qq) { *(LAS u32x4*)(hist + qq * 512 + 256 + 4 * lane) = (u32x4){0u, 0u, 0u, 0u}; }
        LDS_WAIT();
#pragma unroll 1
        for (int qq = 0; qq < 8; ++qq) for (int i = 0; i < 4; ++i) { const unsigned ix = outl[qq * 1024 + lane * 4 + i]; (void)__hip_atomic_fetch_or(hist + qq * 512 + 256 + (ix >> 5), 1u << (ix & 31u), __ATOMIC_RELAXED, __HIP_MEMORY_SCOPE_WORKGROUP); }
        LDS_WAIT();
        run_pass(std::integral_constant<int, 3>{});
#pragma unroll
        for (int g = 0; g < 4; ++g) { float mn = vmin[g], mx = vmax[g];
#pragma unroll
            for (int o = 1; o < 32; o <<= 1) { mn = fminf(mn, __shfl_xor(mn, o)); mx = fmaxf(mx, __shfl_xor(mx, o)); }
            const float scale_ = __uint_as_float((unsigned)(((ecode[g] + 32) >> 5) + 13) << 23);
            if (r == 0 && (mx - mn) > scale_ * TK_VALIDATE_TOL) atomicAdd((int*)(F.ws + WS_CTL) + 64, 1);
            tmn[g] = mn; }
#ifdef TK_VALIDATE_TIES
        run_pass(std::integral_constant<int, 4>{});
#pragma unroll
        for (int g = 0; g < 4; ++g) { int a_ = tsel[g], b_ = tuns[g];
#pragma unroll
            for (int o = 1; o < 32; o <<= 1) { a_ = max(a_, __shfl_xor(a_, o)); b_ = min(b_, __shfl_xor(b_, o)); }
            if (r == 0 && a_ > b_) atomicAdd((int*)(F.ws + WS_CTL) + 64, 1); }
#endif
    }
#endif
#pragma unroll
    for (int qq = 0; qq < 8; ++qq) { const int tok = tok0 + 8 * w + qq;
        if (lane < 32) *(u32x4*)(IDX + (size_t)tok * 256 + lane * 8) = *(const LAS u32x4*)(outl + qq * 1024 + lane * 8); }
    LDS_WAIT();
}
__device__ __forceinline__ void phase_topk(const Frame& F) {
    for (int j = F.bid; j < 256; j += F.G) { const int b = j & 7, pp = j >> 3;
#pragma unroll 1
        for (int u = 0; u < 4; ++u) { const int ch = u == 0 ? 127 - pp : u == 1 ? 64 + pp : u == 2 ? 63 - pp : pp;
#ifdef TK_VALIDATE_OLD
            topk_unit_ref(F, b, ch, (unsigned short*)(F.ws + WS_IDX)); __syncthreads();
#endif
            topk_unit(F, b, ch);
#ifdef TK_XCHECK
            {
                unsigned short* IDX = (unsigned short*)(F.ws + WS_IDX); unsigned short* IDX2 = (unsigned short*)(F.ws + 848 * MiB);
                __syncthreads();
                topk_unit_ref(F, b, ch, IDX2);
                __syncthreads();
                if (64 * (ch + 1) > 256) { LAS unsigned* bm = (LAS unsigned*)(F.lds + F.wave * 16384);
                    for (int qq = 0; qq < 8; ++qq) { const int tok = b * SEQ + 64 * ch + 8 * F.wave + qq;
                        asm volatile("s_waitcnt vmcnt(0)" ::: "memory");
                        *(LAS u32x4*)(bm + 4 * F.lane) = (u32x4){0u, 0u, 0u, 0u}; LDS_WAIT();
                        for (int i = 0; i < 4; ++i) { const unsigned ix = __hip_atomic_load(IDX + (size_t)tok * 256 + F.lane * 4 + i, __ATOMIC_RELAXED, __HIP_MEMORY_SCOPE_AGENT); (void)__hip_atomic_fetch_or(bm + (ix >> 5), 1u << (ix & 31), __ATOMIC_RELAXED, __HIP_MEMORY_SCOPE_WORKGROUP); }
                        LDS_WAIT(); int miss = 0;
                        for (int i = 0; i < 4; ++i) { const unsigned ix = __hip_atomic_load(IDX2 + (size_t)tok * 256 + F.lane * 4 + i, __ATOMIC_RELAXED, __HIP_MEMORY_SCOPE_AGENT); miss += ((bm[ix >> 5] >> (ix & 31)) & 1u) ? 0 : 1; }
                        for (int o = 1; o < 64; o <<= 1) miss += __shfl_xor(miss, o);
                        if (F.lane == 0 && miss > XCHECK_TOL) atomicAdd((int*)(F.ws + WS_CTL) + 64, 1);
                        LDS_WAIT(); } }
                __syncthreads();
            }
#endif
        } }
}

__device__ __forceinline__ unsigned off_b(unsigned row, unsigned ch) { return 256u * row + 16u * (ch ^ (((row & 3u) << 2) | ((row >> 2) & 3u))); }
__device__ __forceinline__ s16x4 tr_read(unsigned lds_addr) { s16x4 r; asm volatile("ds_read_b64_tr_b16 %0, %1\n\ts_waitcnt lgkmcnt(0)" : "=&v"(r) : "v"(lds_addr) : "memory"); return r; }

#define TR8(OFS, T0, T1, T2, T3, T4, T5, T6, T7, H) asm volatile( \
        "ds_read_b64_tr_b16 %0, %8 offset:" #OFS "\n\tds_read_b64_tr_b16 %1, %9 offset:" #OFS "\n\tds_read_b64_tr_b16 %2, %10 offset:" #OFS "\n\tds_read_b64_tr_b16 %3, %11 offset:" #OFS "\n\t" \
        "ds_read_b64_tr_b16 %4, %12 offset:" #OFS "\n\tds_read_b64_tr_b16 %5, %13 offset:" #OFS "\n\tds_read_b64_tr_b16 %6, %14 offset:" #OFS "\n\tds_read_b64_tr_b16 %7, %15 offset:" #OFS "\n\ts_waitcnt lgkmcnt(0)" \
        : "=&v"(T0), "=&v"(T1), "=&v"(T2), "=&v"(T3), "=&v"(T4), "=&v"(T5), "=&v"(T6), "=&v"(T7) \
        : "v"(tra[4 * (H)][0]), "v"(tra[4 * (H)][1]), "v"(tra[4 * (H) + 1][0]), "v"(tra[4 * (H) + 1][1]), "v"(tra[4 * (H) + 2][0]), "v"(tra[4 * (H) + 2][1]), "v"(tra[4 * (H) + 3][0]), "v"(tra[4 * (H) + 3][1]) \
        : "memory")
__device__ __forceinline__ void attn_query(const Frame& F, int b, int t, LAS unsigned char* tile, LAS unsigned short* idxl, const LAS float* biasl, LAS unsigned char* bktl) {
    bf16_t* QLAT = (bf16_t*)(F.ws + WS_QLAT); const bf16_t* C = (const bf16_t*)(F.ws + WS_C); const unsigned short* IDX = (const unsigned short*)(F.ws + WS_IDX);
    const int lane = F.lane, q4 = lane >> 4, hd = lane & 15;
    const int tok = b * SEQ + t, limit = (t / 64 + 1) * 64, nsel = limit < 256 ? limit : 256, niter = nsel / 64;
    if (lane < 32) *(LAS u32x4*)(idxl + lane * 8) = *(const u32x4*)(IDX + (size_t)tok * 256 + lane * 8);
    bf16x8 bq[4];
#pragma unroll
    for (int s = 0; s < 4; ++s) { bq[s] = (bf16x8){0, 0, 0, 0, 0, 0, 0, 0}; if (hd < 8) bq[s] = *(const bf16x8*)(QLAT + (size_t)tok * 1024 + hd * 128 + 32 * s + 8 * q4); }
    LDS_WAIT();
    {
        const u32x2 kk = *(const LAS u32x2*)(idxl + 4 * lane); unsigned pk = 0u;
#pragma unroll
        for (int i = 0; i < 4; ++i) { const int key = (int)((i < 2 ? kk.x : kk.y) >> (16 * (i & 1))) & 0xffff; const int rel = key - t, n = rel < 0 ? -rel : rel;
            int bucket = n < 8 ? n : min(8 + (25 - __clz(n * n)), 15); if (rel > 0) bucket += 16; pk |= (unsigned)bucket << (8 * i); }
        *(LAS unsigned*)(bktl + 4 * lane) = pk;
    }
    f32x4 accO[8];
#pragma unroll
    for (int c = 0; c < 8; ++c) accO[c] = (f32x4){0.f, 0.f, 0.f, 0.f};
    float m_run = -1e30f, l_run = 0.f;
    const bf16_t* cb = C + (size_t)b * SEQ * 128 + hd * 8;
    u32x4 pre[16];
#pragma unroll
    for (int i = 0; i < 16; ++i) { const unsigned key = idxl[q4 + 4 * i]; pre[i] = *(const u32x4*)(cb + (size_t)key * 128); }
    const unsigned tbase = (unsigned)(size_t)tile;
    unsigned tra[8][2];
    { const unsigned qq = (lane & 15) >> 2, pp = lane & 3;
#pragma unroll
      for (int c = 0; c < 8; ++c) { tra[c][0] = tbase + off_b(8u * q4 + qq, 2 * c + (pp >> 1)) + 8u * (pp & 1); tra[c][1] = tbase + off_b(8u * q4 + 4u + qq, 2 * c + (pp >> 1)) + 8u * (pp & 1); } }
#pragma unroll 1
    for (int it = 0; it < niter; ++it) {
#pragma unroll
        for (int i = 0; i < 16; ++i) *(LAS u32x4*)(tile + (i >> 3) * 8192 + off_b(q4 + 4 * (i & 7), hd)) = pre[i];
        if (it + 1 < niter) {
#pragma unroll
            for (int i = 0; i < 16; ++i) { const unsigned key = idxl[64 * (it + 1) + q4 + 4 * i]; pre[i] = *(const u32x4*)(cb + (size_t)key * 128); }
        }
        LDS_WAIT();
        f32x4 sacc[2][2];
#pragma unroll
        for (int u = 0; u < 2; ++u)
#pragma unroll
            for (int rb = 0; rb < 2; ++rb) { sacc[u][rb] = (f32x4){0.f, 0.f, 0.f, 0.f}; const unsigned row = 8u * (hd >> 2) + 4u * rb + (hd & 3);
#pragma unroll
                for (int s = 0; s < 4; ++s) { const bf16x8 A = *(const LAS bf16x8*)(tile + u * 8192 + off_b(row, 4 * s + q4)); sacc[u][rb] = __builtin_amdgcn_mfma_f32_16x16x32_bf16(A, bq[s], sacc[u][rb], 0, 0, 0); } }
        float lg[16]; float mt = -1e30f;
#pragma unroll
        for (int u = 0; u < 2; ++u) { const u32x2 bk8 = *(const LAS u32x2*)(bktl + 64 * it + 32 * u + 8 * q4);
#pragma unroll
            for (int j = 0; j < 8; ++j) { const unsigned bucket = ((j < 4 ? bk8.x : bk8.y) >> (8 * (j & 3))) & 0xffu;
                lg[8 * u + j] = sacc[u][j >> 2][j & 3] + biasl[bucket * 8 + (hd & 7)]; mt = fmaxf(mt, lg[8 * u + j]); } }
        mt = fmaxf(mt, __shfl_xor(mt, 16)); mt = fmaxf(mt, __shfl_xor(mt, 32));
        const float m_new = fmaxf(m_run, mt), alpha = __builtin_amdgcn_exp2f(m_run - m_new); m_run = m_new;
        float pj[16], ps = 0.f;
#pragma unroll
        for (int j = 0; j < 16; ++j) { pj[j] = __builtin_amdgcn_exp2f(lg[j] - m_new); ps += pj[j]; }
        l_run = l_run * alpha + ps;
#pragma unroll
        for (int c = 0; c < 8; ++c) accO[c] = accO[c] * alpha;
        u32x4 pw0, pw1;
        pw0.x = cvt_pk_bf16(pj[0], pj[1]); pw0.y = cvt_pk_bf16(pj[2], pj[3]); pw0.z = cvt_pk_bf16(pj[4], pj[5]); pw0.w = cvt_pk_bf16(pj[6], pj[7]);
        pw1.x = cvt_pk_bf16(pj[8], pj[9]); pw1.y = cvt_pk_bf16(pj[10], pj[11]); pw1.z = cvt_pk_bf16(pj[12], pj[13]); pw1.w = cvt_pk_bf16(pj[14], pj[15]);
        const bf16x8 pf0 = __builtin_bit_cast(bf16x8, pw0), pf1 = __builtin_bit_cast(bf16x8, pw1);
#define PV4(PF, H, T0, T1, T2, T3, T4, T5, T6, T7) do { \
        accO[4 * (H)]     = __builtin_amdgcn_mfma_f32_16x16x32_bf16(__builtin_shufflevector(T0, T1, 0, 1, 2, 3, 4, 5, 6, 7), PF, accO[4 * (H)], 0, 0, 0); \
        accO[4 * (H) + 1] = __builtin_amdgcn_mfma_f32_16x16x32_bf16(__builtin_shufflevector(T2, T3, 0, 1, 2, 3, 4, 5, 6, 7), PF, accO[4 * (H) + 1], 0, 0, 0); \
        accO[4 * (H) + 2] = __builtin_amdgcn_mfma_f32_16x16x32_bf16(__builtin_shufflevector(T4, T5, 0, 1, 2, 3, 4, 5, 6, 7), PF, accO[4 * (H) + 2], 0, 0, 0); \
        accO[4 * (H) + 3] = __builtin_amdgcn_mfma_f32_16x16x32_bf16(__builtin_shufflevector(T6, T7, 0, 1, 2, 3, 4, 5, 6, 7), PF, accO[4 * (H) + 3], 0, 0, 0); } while (0)
        { s16x4 t0, t1, t2, t3, t4, t5, t6, t7;
          TR8(0, t0, t1, t2, t3, t4, t5, t6, t7, 0); PV4(pf0, 0, t0, t1, t2, t3, t4, t5, t6, t7);
          TR8(0, t0, t1, t2, t3, t4, t5, t6, t7, 1); PV4(pf0, 1, t0, t1, t2, t3, t4, t5, t6, t7);
          TR8(8192, t0, t1, t2, t3, t4, t5, t6, t7, 0); PV4(pf1, 0, t0, t1, t2, t3, t4, t5, t6, t7);
          TR8(8192, t0, t1, t2, t3, t4, t5, t6, t7, 1); PV4(pf1, 1, t0, t1, t2, t3, t4, t5, t6, t7); }
#undef PV4
    }
    float lt = l_run; lt += __shfl_xor(lt, 16); lt += __shfl_xor(lt, 32);
    const float inv = 1.0f / lt;
    if (hd < 8) {
#pragma unroll
        for (int c = 0; c < 8; ++c) { u32x2 o; o.x = cvt_pk_bf16(accO[c][0] * inv, accO[c][1] * inv); o.y = cvt_pk_bf16(accO[c][2] * inv, accO[c][3] * inv);
            *(u32x2*)(QLAT + (size_t)tok * 1024 + hd * 128 + 16 * c + 4 * q4) = o; }
    }
    LDS_WAIT();
}
__device__ __forceinline__ void phase_attn(const Frame& F, const Params& p) {
    LAS unsigned char* tile = F.lds + F.wave * 16384;
    LAS unsigned short* idxl = (LAS unsigned short*)(F.lds + LDS_GEMM + LDS_MISC + F.wave * 512);
    LAS float* biasl = (LAS float*)(F.lds + LDS_GEMM + LDS_MISC + 8 * 512);
    LAS unsigned char* bktl = F.lds + LDS_GEMM + LDS_MISC + 8 * 512 + 1024 + F.wave * 256;
    if (F.tid < 256) biasl[F.tid] = INP(6)[F.tid] * 1.44269504f;
    __syncthreads();
    if (F.G % 8 == 0) {
        const int per = F.G / 8, b = F.bid & 7, slot = F.bid >> 3;
        for (int t = slot * 8 + F.wave; t < SEQ; t += per * 8) attn_query(F, b, t, tile, idxl, biasl, bktl);
    } else {
        for (int m = F.gw; m < MTOK; m += F.NGW) attn_query(F, m / SEQ, m % SEQ, tile, idxl, biasl, bktl);
    }
}

__device__ __forceinline__ void phase_scan(const Frame& F) {
    const int gt = F.bid * NT + F.tid; if (gt >= NB * 32 * 64) return;
    const int n = gt & 63, g = (gt >> 6) & 31, b = gt >> 11;
    const float* a64 = (const float*)(F.ws + WS_CTL + 1024); const float ar = a64[(g * 64 + n) * 2], ai = a64[(g * 64 + n) * 2 + 1];
    const float* SST = (const float*)(F.ws + WS_SST) + ((size_t)g * 1024 + b * 128) * 128 + n;
    bf16_t* UG = (bf16_t*)(F.ws + WS_UG) + ((size_t)g * 1024 + b * 128) * UGP + 1024 + n;
    float xr = 0.f, xi = 0.f;
    for (int c0 = 0; c0 < 128; c0 += 8) {
        float sr[8], si[8];
#pragma unroll
        for (int k = 0; k < 8; ++k) { sr[k] = SST[(size_t)(c0 + k) * 128]; si[k] = SST[(size_t)(c0 + k) * 128 + 64]; }
#pragma unroll
        for (int k = 0; k < 8; ++k) { bf16_t* u = UG + (size_t)(c0 + k) * UGP; u[0] = f2bf(xr); u[64] = f2bf(xi);
            const float nr = ar * xr - ai * xi + sr[k], ni = ar * xi + ai * xr + si[k]; xr = nr; xi = ni; }
    }
}

__device__ __forceinline__ void route_decide(const Params& p, const float* lg, int& x0o, int& x1o, float& w0o, float& w1o) {
    const f32x4 g4 = *(const f32x4*)lg + *(const f32x4*)INP(22);
    int grp = 0; float gm = g4[0];
#pragma unroll
    for (int k = 1; k < 4; ++k) if (g4[k] > gm) { gm = g4[k]; grp = k; }
    float gs = 0.f;
#pragma unroll
    for (int k = 0; k < 4; ++k) gs += expf(g4[k] - gm);
    const float gval = 1.0f / gs;
    const float* el = lg + 4 + grp * 8; const float* eb = INP(24) + grp * 8;
    const f32x4 e0 = *(const f32x4*)el + *(const f32x4*)eb, e1 = *(const f32x4*)(el + 4) + *(const f32x4*)(eb + 4);
    float ev[8] = {e0[0], e0[1], e0[2], e0[3], e1[0], e1[1], e1[2], e1[3]};
    float em = ev[0];
#pragma unroll
    for (int k = 1; k < 8; ++k) em = fmaxf(em, ev[k]);
    float pe[8];
#pragma unroll
    for (int k = 0; k < 8; ++k) pe[k] = expf(ev[k] - em);
    int i1 = 0; float p1 = pe[0];
#pragma unroll
    for (int k = 1; k < 8; ++k) if (pe[k] > p1) { p1 = pe[k]; i1 = k; }
    int i2 = -1; float p2 = -1.f;
#pragma unroll
    for (int k = 0; k < 8; ++k) if (k != i1 && pe[k] > p2) { p2 = pe[k]; i2 = k; }
    const float wn = gval / (p1 + p2);
    x0o = grp * 8 + i1; x1o = grp * 8 + i2; w0o = p1 * wn; w1o = p2 * wn;
}
__device__ __forceinline__ void phase_route(const Frame& F, const Params& p) {
    const float* X1 = p.out; bf16_t* H2X = (bf16_t*)(F.ws + WS_H2X); int* cnt = (int*)(F.ws + WS_CTL); int* tokinfo = (int*)(F.ws + WS_TOKINFO); float* LOG = (float*)(F.ws + WS_LOGITS);
    const int lane = F.lane; const float* gain = INP(20);
    for (int rt = F.bid; rt < MTOK / 256; rt += F.G) {
        int ln = F.lane; asm volatile("" : "+v"(ln));
        for (int rr = 0; rr < 32; rr += 4) {
            f32x4 v[4][4]; float ss[4];
#pragma unroll
            for (int u = 0; u < 4; ++u) { const float* xr = X1 + (size_t)(rt * 256 + F.wave * 32 + rr + u) * 1024;
#pragma unroll
                for (int j = 0; j < 4; ++j) v[u][j] = *(const f32x4*)(xr + 256 * j + 4 * ln); }
#pragma unroll
            for (int u = 0; u < 4; ++u) { float s = 0.f;
#pragma unroll
                for (int j = 0; j < 4; ++j) s += (v[u][j].x * v[u][j].x + v[u][j].y * v[u][j].y) + (v[u][j].z * v[u][j].z + v[u][j].w * v[u][j].w);
                ss[u] = s; }
#pragma unroll
            for (int o = 1; o < 64; o <<= 1) {
#pragma unroll
                for (int u = 0; u < 4; ++u) ss[u] += __shfl_xor(ss[u], o); }
#pragma unroll
            for (int u = 0; u < 4; ++u) { const int row = rt * 256 + F.wave * 32 + rr + u; const float rstd = 1.0f / sqrtf(ss[u] * (1.0f / 1024.0f) + EPS);
#pragma unroll
                for (int j = 0; j < 4; ++j) { const f32x4 h = v[u][j] * rstd * *(const f32x4*)(gain + 256 * j + 4 * ln);
                    u32x2 o; o.x = cvt_pk_bf16(h.x, h.y); o.y = cvt_pk_bf16(h.z, h.w);
                    u32x2 l; l.x = cvt_pk_bf16(h.x - bflo(o.x), h.y - bfhi(o.x)); l.y = cvt_pk_bf16(h.z - bflo(o.y), h.w - bfhi(o.y));
                    *(u32x2*)(H2X + (size_t)row * 2048 + 256 * j + 4 * ln) = o; *(u32x2*)(H2X + (size_t)row * 2048 + 1024 + 256 * j + 4 * ln) = l; } }
        }
        RSTAMP(32);
        asm volatile("s_waitcnt vmcnt(0)" ::: "memory"); __builtin_amdgcn_fence(__ATOMIC_ACQUIRE, "agent"); asm volatile("s_waitcnt vmcnt(0)" ::: "memory"); __syncthreads();
        { pg8::Gemm g{H2X, (const bf16_t*)(F.ws + WS_WR), 2048, 2048, 2048};
          pg8::Sched S; S.mode = 3; S.nM = 1; S.nN = 1; S.nwg = 1; S.G = 1; S.c = rt; S.tstepA = (size_t)256 * 2048 * 2; S.tstepB = 0; S.zstepA = 0; S.zstepB = 0; S.tile_e = nullptr;
          RSTAMP(33);
          EpiRouter E{LOG}; pg8::gemm_phase(F.lds, g, S, E); }
        RSTAMP(34);
        asm volatile("s_waitcnt vmcnt(0)" ::: "memory"); __builtin_amdgcn_fence(__ATOMIC_ACQUIRE, "agent"); asm volatile("s_waitcnt vmcnt(0)" ::: "memory"); __syncthreads();
        {
            LAS int* cl = (LAS int*)(F.lds + LDS_GEMM);
            int td = threadIdx.x; asm volatile("" : "+v"(td));
            if (td < 64) cl[td] = 0;
            __syncthreads();
            int x0 = 0, x1 = 0, l0 = 0, l1 = 0; float w0 = 0.f, w1 = 0.f;
            if (td < 256) { route_decide(p, LOG + (size_t)(rt * 256 + td) * 64, x0, x1, w0, w1);
                l0 = __hip_atomic_fetch_add(cl + x0, 1, __ATOMIC_RELAXED, __HIP_MEMORY_SCOPE_WORKGROUP); l1 = __hip_atomic_fetch_add(cl + x1, 1, __ATOMIC_RELAXED, __HIP_MEMORY_SCOPE_WORKGROUP); }
            __syncthreads();
            if (td < 32) { const int c = cl[td]; cl[32 + td] = c ? atomicAdd(cnt + td, c) : 0; }
            __syncthreads();
            if (td < 256) { int* ti = tokinfo + (size_t)(rt * 256 + td) * 8; ti[0] = x0; ti[1] = cl[32 + x0] + l0; ti[2] = x1; ti[3] = cl[32 + x1] + l1; ((float*)ti)[4] = w0; ((float*)ti)[5] = w1; }
            __syncthreads();
        }
    }
}
__device__ __forceinline__ int expert_base(const Frame& F, int* tot) {
    const int* cnt = (const int*)(F.ws + WS_CTL);
    const int c = F.lane < 32 ? cnt[F.lane] : 0; const int pd = (c + 255) & ~255;
    int inc = pd;
#pragma unroll
    for (int off = 1; off < 64; off <<= 1) { const int v = __shfl_up(inc, off); if (F.lane >= off) inc += v; }
    *tot = __shfl(inc, 63);
    return inc - pd;
}
__device__ __forceinline__ void phase_scatter(const Frame& F) {
    const bf16_t* H2 = (const bf16_t*)(F.ws + WS_H2X); bf16_t* XS = (bf16_t*)(F.ws + WS_XS); const int* tokinfo = (const int*)(F.ws + WS_TOKINFO); int* tokslot = (int*)(F.ws + WS_TOKSLOT);
    int tot; const int base = expert_base(F, &tot);
    for (int m = F.gw; m < MTOK; m += F.NGW) {
        const int* ti = tokinfo + (size_t)m * 8; const int e0 = ti[0], pos0 = ti[1], e1 = ti[2], pos1 = ti[3];
        const int s0 = __shfl(base, e0) + pos0, s1 = __shfl(base, e1) + pos1;
        const u32x4 a = *(const u32x4*)(H2 + (size_t)m * 2048 + 8 * F.lane), bb = *(const u32x4*)(H2 + (size_t)m * 2048 + 512 + 8 * F.lane);
        *(u32x4*)(XS + (size_t)s0 * 1024 + 8 * F.lane) = a; *(u32x4*)(XS + (size_t)s0 * 1024 + 512 + 8 * F.lane) = bb;
        *(u32x4*)(XS + (size_t)s1 * 1024 + 8 * F.lane) = a; *(u32x4*)(XS + (size_t)s1 * 1024 + 512 + 8 * F.lane) = bb;
        if (F.lane == 0) { tokslot[(size_t)m * 2] = s0; tokslot[(size_t)m * 2 + 1] = s1; }
    }
}
__device__ __forceinline__ int build_tile_table(const Frame& F, LAS int* tile_e) {
    const int* cnt = (const int*)(F.ws + WS_CTL);
    int total = 0; int tid_ = threadIdx.x; asm volatile("" : "+v"(tid_));
    for (int rt = tid_; rt < MOE_ROWS / 256; rt += NT) { int acc = 0, e = 31;
        for (int k = 0; k < 32; ++k) { const int nt_ = (cnt[k] + 255) >> 8; if (rt >= acc && rt < acc + nt_) e = k; acc += nt_; }
        tile_e[rt] = e; }
    for (int k = 0; k < 32; ++k) total += (cnt[k] + 255) >> 8;
    __syncthreads();
    return total;
}
__device__ __forceinline__ void phase_final(const Frame& F, const Params& p) {
    const bf16_t* YS = (const bf16_t*)(F.ws + WS_YS); const int* tokinfo = (const int*)(F.ws + WS_TOKINFO); const int* tokslot = (const int*)(F.ws + WS_TOKSLOT);
    const float* gain = INP(28); const int lane = F.lane;
#if defined(TK_XCHECK) || defined(TK_VALIDATE)
    const float poison = ((const int*)(F.ws + WS_CTL))[64] > 0 ? __builtin_nanf("") : 1.0f;
#else
    const float poison = 1.0f;
#endif
    for (int m = F.gw; m < MTOK; m += F.NGW) {
        const int s0 = tokslot[(size_t)m * 2], s1 = tokslot[(size_t)m * 2 + 1]; const float w0 = ((const float*)(tokinfo + (size_t)m * 8))[4], w1 = ((const float*)(tokinfo + (size_t)m * 8))[5];
        float* xr = p.out + (size_t)m * 1024; f32x4 v[4]; float s = 0.f;
#pragma unroll
        for (int j = 0; j < 4; ++j) { v[j] = *(const f32x4*)(xr + 256 * j + 4 * lane);
            const u32x2 a = *(const u32x2*)(YS + (size_t)s0 * 1024 + 256 * j + 4 * lane), bb = *(const u32x2*)(YS + (size_t)s1 * 1024 + 256 * j + 4 * lane);
            v[j].x += w0 * bflo(a.x) + w1 * bflo(bb.x); v[j].y += w0 * bfhi(a.x) + w1 * bfhi(bb.x); v[j].z += w0 * bflo(a.y) + w1 * bflo(bb.y); v[j].w += w0 * bfhi(a.y) + w1 * bfhi(bb.y);
            s += (v[j].x * v[j].x + v[j].y * v[j].y) + (v[j].z * v[j].z + v[j].w * v[j].w); }
        const float rstd = 1.0f / sqrtf(wave_sum(s) * (1.0f / 1024.0f) + EPS);
#pragma unroll
        for (int j = 0; j < 4; ++j) { const f32x4 gg = *(const f32x4*)(gain + 256 * j + 4 * lane); *(f32x4*)(xr + 256 * j + 4 * lane) = v[j] * (rstd * poison) * gg; }
    }
}

#define XB_TMO      128
#define XB_XCNT(j)  (256  + 64 * (j))
#define XB_XSUB(j)  (1280 + 64 * (j))
#define XB_XGEN(j)  (2304 + 64 * (j))
#define XB_TOP      3328
#define XB_TOPGEN   3392
#define XCD_BAR_WORDS 3456
#define XB_SPIN_CAP (1u << 18)
__device__ __forceinline__ unsigned xb_ld(unsigned* p)              { return __hip_atomic_load(p, __ATOMIC_RELAXED, __HIP_MEMORY_SCOPE_AGENT); }
__device__ __forceinline__ unsigned xb_add(unsigned* p, unsigned v) { return __hip_atomic_fetch_add(p, v, __ATOMIC_RELAXED, __HIP_MEMORY_SCOPE_AGENT); }
__device__ __forceinline__ unsigned xb_xcc_id() { return (unsigned)__builtin_amdgcn_s_getreg((3 << 11) | 20) & 0xFu; }
#define XB_SPIN(cond, bar) do { unsigned _sp = 0; while (cond) { __builtin_amdgcn_s_sleep(1); \
    if ((++_sp & 255u) == 0u) { if (xb_ld(&(bar)[XB_TMO])) break; if (_sp > XB_SPIN_CAP) { atomicAdd(&(bar)[XB_TMO], 1u); break; } } } } while (0)
struct XcdBarrier { unsigned* bar; unsigned x; volatile LAS unsigned* st; };
__device__ __forceinline__ XcdBarrier xcd_barrier_post(unsigned* bar, volatile LAS unsigned* st) {
    XcdBarrier b; b.bar = bar; b.x = xb_xcc_id(); b.st = st;
    if (threadIdx.x == 0) (void)xb_add(&bar[XB_XCNT(b.x)], 1u);
    return b;
}
__device__ __forceinline__ void xcd_barrier_complete(unsigned* bar, unsigned x, unsigned& nloc, unsigned& nx) {
    const unsigned G = gridDim.x * gridDim.y * gridDim.z;
    unsigned sum, cnt, mine, sp = 0u;
    for (;;) {
        sum = 0u; cnt = 0u; mine = 0u;
#pragma unroll
        for (unsigned j = 0; j < 16; ++j) { const unsigned c = xb_ld(&bar[XB_XCNT(j)]); sum += c; cnt += (c > 0u) ? 1u : 0u; mine = (j == x) ? c : mine; }
        if (sum == G) break;
        __builtin_amdgcn_s_sleep(1);
        if ((++sp & 255u) == 0u) { if (xb_ld(&bar[XB_TMO])) break; if (sp > XB_SPIN_CAP) { atomicAdd(&bar[XB_TMO], 1u); break; } }
    }
    nloc = mine > 0u ? mine : 1u; nx = cnt > 0u ? cnt : 1u;
}
__device__ __forceinline__ void xcd_barrier(const XcdBarrier& b) {
    asm volatile("s_waitcnt vmcnt(0)" ::: "memory");
    __syncthreads();
    if (threadIdx.x == 0) {
        unsigned* bar = b.bar;
        __builtin_amdgcn_s_waitcnt(0);
        unsigned nloc = b.st[0], nx = b.st[1];
        if (nloc == 0u) { xcd_barrier_complete(bar, b.x, nloc, nx); b.st[0] = nloc; b.st[1] = nx; }
        const unsigned old = xb_add(&bar[XB_XSUB(b.x)], 1u);
        const unsigned gen = old / nloc;
        if (old + 1u == (gen + 1u) * nloc) {
            __builtin_amdgcn_fence(__ATOMIC_RELEASE, "agent");
            asm volatile("s_waitcnt vmcnt(0)" ::: "memory");
            const unsigned og = xb_add(&bar[XB_TOP], 1u);
            const unsigned tg = og / nx;
            if (og + 1u == (tg + 1u) * nx) xb_add(&bar[XB_TOPGEN], 1u);
            else XB_SPIN(xb_ld(&bar[XB_TOPGEN]) == tg, bar);
            __builtin_amdgcn_fence(__ATOMIC_ACQUIRE, "agent");
            xb_add(&bar[XB_XGEN(b.x)], 1u);
            asm volatile("s_waitcnt vmcnt(0)" ::: "memory");
        } else {
            XB_SPIN(xb_ld(&bar[XB_XGEN(b.x)]) == gen, bar);
            __builtin_amdgcn_fence(__ATOMIC_ACQUIRE, "agent");
            asm volatile("s_waitcnt vmcnt(0)" ::: "memory");
        }
    }
    __syncthreads();
}

__global__ void __launch_bounds__(NT, 2) mk_fwd(Params p) {
    __builtin_assume(__builtin_amdgcn_workitem_id_y() == 0); __builtin_assume(__builtin_amdgcn_workitem_id_z() == 0);
    extern __shared__ __attribute__((aligned(16))) unsigned char lds_raw[];
    cg::grid_group grid = cg::this_grid();
    Frame F; F.lds = (LAS unsigned char*)lds_raw; F.tid = threadIdx.x; F.lane = F.tid & 63; F.wave = __builtin_amdgcn_readfirstlane(F.tid >> 6);
    F.G = gridDim.x; F.bid = blockIdx.x; F.gw = F.bid * NWAVES + F.wave; F.NGW = F.G * NWAVES; F.ws = p.ws;
    unsigned char* ws = p.ws;
    LAS int* tile_e = (LAS int*)(F.lds + LDS_GEMM);
    volatile LAS unsigned* xst = (volatile LAS unsigned*)(F.lds + LDS_GEMM + 3584);
    if (F.tid == 0) { xst[0] = 0u; xst[1] = 0u; }
    __syncthreads();
    XcdBarrier xbar = xcd_barrier_post((unsigned*)(ws + WS_BAR), xst);
#ifndef PROBE_A
#define PROBE_A -1
#define PROBE_B -1
#endif
#ifndef PROBE_BID
#define PROBE_BID 0
#endif
    LAS unsigned long long* stamps = (LAS unsigned long long*)(F.lds + LDS_GEMM + 3072);
#define STAMP(i) do { if (PROBE_A >= 0 && F.bid == PROBE_BID && F.tid == 0) stamps[i] = __builtin_amdgcn_s_memrealtime(); } while (0)
    if (PROBE_A >= 0 && F.bid == PROBE_BID && F.tid == 0) { for (int i = 40; i < 50; ++i) stamps[i] = 0; }
    STAMP(0);
#define IN(k) (p.ph_lo <= (k) && (k) < p.ph_hi)
#define SYNC(k) do { if (IN(k) && IN((k) + 1)) { if ((k) == 0) grid.sync(); else xcd_barrier(xbar); } } while (0)
    if (IN(0)) phase0(F, p);
    SYNC(0); STAMP(1);
    if (IN(1)) {
        expand_tt(F);
        __syncthreads(); STAMP(20);
        pg8::Gemm g{(const bf16_t*)(ws + WS_H), (const bf16_t*)(ws + WS_WIN), 1024, 1024, 1024}; pg8::Sched S = sched_dense(F, MTOK, NIN, 1024, 1024);
        EpiInProj E{(bf16_t*)(ws + WS_Q), (bf16_t*)(ws + WS_MID), (bf16_t*)(ws + WS_UG), (bf16_t*)(ws + WS_GATES), INP(18)};
        pg8::gemm_phase(F.lds, g, S, E);
        { pg8::Gemm g2{(const bf16_t*)(ws + WS_WUPA), (const bf16_t*)(ws + WS_WO), 512, 512, 512}; pg8::Sched S2 = sched_dense(F, 1024, 1024, 512, 512);
          EpiPlain E2{(bf16_t*)(ws + WS_WC), 1024, 0}; pg8::gemm_phase(F.lds, g2, S2, E2); }
    }
    SYNC(1); STAMP(2);
    if (IN(2)) {
        { pg8::Gemm g{(const bf16_t*)(ws + WS_Q), (const bf16_t*)(ws + WS_WQL), 512, 512, 512}; pg8::Sched S = sched_dense(F, MTOK, 1024, 512, 512);
          EpiPlain E{(bf16_t*)(ws + WS_QLAT), 1024, 0}; pg8::gemm_phase(F.lds, g, S, E); }
        STAMP(21);
        { pg8::Gemm g{(const bf16_t*)(ws + WS_UG), (const bf16_t*)(ws + WS_WST), UGP, 1024, 1024}; pg8::Sched S = sched_batch(F, 32, 4, 1, UGP, 1024, (size_t)1024 * UGP * 2, (size_t)256 * 1024 * 2);
          EpiSst E{(float*)(ws + WS_SST)}; pg8::gemm_phase(F.lds, g, S, E); }
        __syncthreads(); STAMP(22);
        phase_cnorm(F, p); STAMP(23);
        phase_topk(F); STAMP(24);
    }
    SYNC(2); STAMP(3);
    if (IN(3)) { phase_scan(F); STAMP(25); phase_attn(F, p); STAMP(26); }
    SYNC(3); STAMP(4);
    if (IN(4)) {
        { pg8::Gemm g{(const bf16_t*)(ws + WS_UG), (const bf16_t*)(ws + WS_TT), UGP, UGP, UGP}; pg8::Sched S = sched_batch(F, 32, 4, 4, UGP, UGP, (size_t)1024 * UGP * 2, (size_t)1024 * UGP * 2);
          EpiS5Out E{(bf16_t*)(ws + WS_Z)}; pg8::gemm_phase(F.lds, g, S, E); }
        STAMP(27);
    }
    SYNC(4); STAMP(5);
    if (IN(5)) {
        { pg8::Gemm g{(const bf16_t*)(ws + WS_Z), (const bf16_t*)(ws + WS_WGLU), 512, 512, 512}; pg8::Sched S = sched_dense(F, MTOK, 1024, 512, 512);
          EpiGlu<0> E{(bf16_t*)(ws + WS_S5OUT), 512}; pg8::gemm_phase(F.lds, g, S, E); }
        STAMP(28);
        { pg8::Gemm g{(const bf16_t*)(ws + WS_QLAT), (const bf16_t*)(ws + WS_WC), 1024, 1024, 1024}; pg8::Sched S = sched_dense(F, MTOK, 1024, 1024, 1024);
          EpiGateMul E{(bf16_t*)(ws + WS_T), (const bf16_t*)(ws + WS_GATES), 0, nullptr}; pg8::gemm_phase(F.lds, g, S, E); }
    }
    SYNC(5); STAMP(6);
    if (IN(6)) {
        pg8::Gemm g{(const bf16_t*)(ws + WS_S5OUT), (const bf16_t*)(ws + WS_WUPB), 512, 512, 512}; pg8::Sched S = sched_dense(F, MTOK, 1024, 512, 512);
        EpiGateMul E{(bf16_t*)(ws + WS_MIXIN), (const bf16_t*)(ws + WS_GATES), 1024, (const bf16_t*)(ws + WS_T)}; pg8::gemm_phase(F.lds, g, S, E);
    }
    SYNC(6); STAMP(7);
    if (IN(7)) {
        pg8::Gemm g{(const bf16_t*)(ws + WS_MIXIN), (const bf16_t*)(ws + WS_WOUT), 1024, 1024, 1024}; pg8::Sched S = sched_dense(F, MTOK, 1024, 1024, 1024);
        EpiResid E{INP(0), p.out}; pg8::gemm_phase(F.lds, g, S, E);
    }
    SYNC(7); STAMP(8);
    if (IN(8)) phase_route(F, p);
    SYNC(8); STAMP(9);
    if (IN(9)) phase_scatter(F);
    SYNC(9); STAMP(10);
    if (IN(10)) {
        const int ntiles = build_tile_table(F, tile_e);
        pg8::Gemm g{(const bf16_t*)(ws + WS_XS), (const bf16_t*)(ws + WS_WGU), 1024, 1024, 1024};
        pg8::Sched S; S.mode = 2; S.nM = ntiles; S.nN = 4; S.nwg = ntiles * 4; S.G = F.G; S.c = F.bid; S.tstepA = (size_t)256 * 1024 * 2; S.tstepB = (size_t)256 * 1024 * 2; S.zstepA = 0; S.zstepB = (size_t)1024 * 1024 * 2; S.tile_e = tile_e;
        EpiGlu<1> E{(bf16_t*)(ws + WS_HB), 512}; pg8::gemm_phase(F.lds, g, S, E);
    }
    SYNC(10); STAMP(11);
    if (IN(11)) {
        const int ntiles = build_tile_table(F, tile_e);
        pg8::Gemm g{(const bf16_t*)(ws + WS_HB), (const bf16_t*)(ws + WS_WD), 512, 512, 512};
        pg8::Sched S; S.mode = 2; S.nM = ntiles; S.nN = 4; S.nwg = ntiles * 4; S.G = F.G; S.c = F.bid; S.tstepA = (size_t)256 * 512 * 2; S.tstepB = (size_t)256 * 512 * 2; S.zstepA = 0; S.zstepB = (size_t)1024 * 512 * 2; S.tile_e = tile_e;
        EpiPlain E{(bf16_t*)(ws + WS_YS), 1024, 0}; pg8::gemm_phase(F.lds, g, S, E);
    }
    SYNC(11); STAMP(12);
    if (IN(12)) phase_final(F, p);
    STAMP(13);
    if (PROBE_A >= 0 && F.bid == PROBE_BID && F.tid == 0) { const unsigned long long dt = stamps[PROBE_B] - stamps[PROBE_A], t0 = __builtin_amdgcn_s_memrealtime();
        while (__builtin_amdgcn_s_memrealtime() - t0 < dt) __builtin_amdgcn_s_sleep(8); }
#undef IN
#undef SYNC
}

extern "C" void kernel_launch(void* const* d_in, const int* in_sizes, int n_in, void* d_out, int out_size, void* d_ws, size_t ws_size, hipStream_t stream) {
    static int grid_blocks = 0;
    if (!grid_blocks) {
        if (n_in != 29 || out_size != MTOK * DM || ws_size < WS_END) { fprintf(stderr, "kernel_launch: unexpected shapes (n_in %d out %d ws %zu, need ws %zu)\n", n_in, out_size, ws_size, (size_t)WS_END); grid_blocks = -1; return; }
        int dev = 0, cus = 0, per_cu = 0;
        (void)hipGetDevice(&dev);
        (void)hipDeviceGetAttribute(&cus, hipDeviceAttributeMultiprocessorCount, dev);
        (void)hipFuncSetAttribute((const void*)mk_fwd, hipFuncAttributeMaxDynamicSharedMemorySize, LDS_BYTES);
        (void)hipOccupancyMaxActiveBlocksPerMultiprocessor(&per_cu, (const void*)mk_fwd, NT, LDS_BYTES);
        if (per_cu < 1) { fprintf(stderr, "kernel_launch: occupancy query reports %d blocks per CU\n", per_cu); per_cu = 1; }
        grid_blocks = cus;
        fprintf(stderr, "kernel_launch: grid %d (cus %d, per_cu %d)\n", grid_blocks, cus, per_cu);
    }
    if (grid_blocks < 0) return;
    (void)hipMemsetAsync((char*)d_ws + WS_BAR, 0, XCD_BAR_WORDS * sizeof(unsigned), stream);
    Params p{};
    for (int i = 0; i < 29; ++i) p.in[i] = (const float*)d_in[i];
    p.out = (float*)d_out; p.ws = (unsigned char*)d_ws; p.ph_lo = 0; p.ph_hi = 13;
    void* args[] = {&p};
    hipError_t e = hipLaunchCooperativeKernel((const void*)mk_fwd, dim3(grid_blocks), dim3(NT), args, LDS_BYTES, stream);
    if (e != hipSuccess) fprintf(stderr, "cooperative launch failed: %s (grid %d)\n", hipGetErrorString(e), grid_blocks);
}
```

```cpp
#include <hip/hip_runtime.h>
#include <hip/hip_cooperative_groups.h>
#include <cstdio>
#include <cstdint>
#include <cmath>
#include <type_traits>
namespace cg = cooperative_groups;

#define LAS __attribute__((address_space(3)))
typedef unsigned short bf16_t;
typedef short bf16x8 __attribute__((ext_vector_type(8)));
typedef short s16x4 __attribute__((ext_vector_type(4)));
typedef float f32x4 __attribute__((ext_vector_type(4)));
typedef float f32x2 __attribute__((ext_vector_type(2)));
typedef float f32x16 __attribute__((ext_vector_type(16)));
typedef unsigned u32x4 __attribute__((ext_vector_type(4)));
typedef unsigned u32x2 __attribute__((ext_vector_type(2)));
typedef unsigned short u16x8 __attribute__((ext_vector_type(8)));

constexpr int DM = 1024, NB = 8, SEQ = 8192, MTOK = NB * SEQ;
constexpr int NT = 512, NWAVES = 8;
constexpr int NIN = 3584;
constexpr int UGP = 1152;
constexpr int MOE_ROWS = 139264;
constexpr float EPS = 1e-6f;

constexpr size_t MiB = 1ull << 20;
constexpr size_t WS_WIN = 0 * MiB, WS_WQL = 7 * MiB, WS_WO = 8 * MiB, WS_WUPA = 9 * MiB, WS_WGLU = 10 * MiB, WS_WUPB = 11 * MiB, WS_WOUT = 12 * MiB,
                 WS_WST = 14 * MiB, WS_TT = 30 * MiB, WS_WGU = 102 * MiB, WS_WD = 166 * MiB, WS_KBUF = 198 * MiB,
                 WS_GATES = 200 * MiB, WS_XS = 200 * MiB, WS_YS = 200 * MiB,
                 WS_H = 456 * MiB, WS_QLAT = 456 * MiB, WS_MIXIN = 456 * MiB,
                 WS_Q = 584 * MiB, WS_Z = 584 * MiB, WS_H2X = 472 * MiB,
                 WS_MID = 648 * MiB, WS_O = 648 * MiB,
                 WS_UG = 712 * MiB, WS_T = 712 * MiB, WS_HB = 712 * MiB,
                 WS_C = 784 * MiB, WS_IDX = 800 * MiB, WS_SST = 832 * MiB, WS_S5OUT = 848 * MiB,
                 WS_LOGITS = 848 * MiB, WS_TOKINFO = 912 * MiB, WS_TOKSLOT = 914 * MiB, WS_CTL = 915 * MiB, WS_WR = 916 * MiB, WS_WC = 917 * MiB, WS_END = 919 * MiB;
constexpr size_t WS_BAR = WS_CTL + 65536;
constexpr int LDS_GEMM = 131072, LDS_MISC = 5120, LDS_KT = 3 * 9216, LDS_BYTES = LDS_GEMM + LDS_MISC + LDS_KT;

struct Params {
    const float* in[29];
    float* out;
    unsigned char* ws;
    int ph_lo, ph_hi;
};

__device__ __forceinline__ const float* in_ptr(int k) {
    const char __attribute__((address_space(4)))* ka = (const char __attribute__((address_space(4)))*)__builtin_amdgcn_kernarg_segment_ptr();
    asm volatile("" : "+s"(ka));
    return *(const float* const __attribute__((address_space(4)))*)(ka + 8 * k);
}
#define INP(k) in_ptr(k)
__device__ __forceinline__ unsigned cvt_pk_bf16(float lo, float hi) { unsigned r; asm volatile("v_cvt_pk_bf16_f32 %0, %1, %2" : "=v"(r) : "v"(lo), "v"(hi)); return r; }
__device__ __forceinline__ bf16_t f2bf(float f) { unsigned u = __builtin_bit_cast(unsigned, f); return (bf16_t)((u + 0x7fffu + ((u >> 16) & 1u)) >> 16); }
__device__ __forceinline__ float bf2f(bf16_t h) { return __builtin_bit_cast(float, (unsigned)h << 16); }
__device__ __forceinline__ float bflo(unsigned w) { return __builtin_bit_cast(float, w << 16); }
__device__ __forceinline__ float bfhi(unsigned w) { return __builtin_bit_cast(float, w & 0xffff0000u); }
__device__ __forceinline__ float wave_sum(float v) {
#pragma unroll
    for (int o = 1; o < 64; o <<= 1) v += __shfl_xor(v, o);
    return v;
}
__device__ __forceinline__ float sigmoidf_(float x) { return 1.0f / (1.0f + __expf(-x)); }
__device__ __forceinline__ float gelu_tanh(float x) { const float u = 0.7978845608028654f * (x + 0.044715f * x * x * x); return x / (1.0f + __expf(-2.0f * u)); }
#define LDS_WAIT() asm volatile("s_waitcnt lgkmcnt(0)" ::: "memory")
#ifdef PROBE_SET
#define RSTAMP(i) do { if (F.bid == PROBE_BID && F.tid == 0) ((LAS unsigned long long*)(F.lds + 131072 + 4096))[i] = __builtin_amdgcn_s_memrealtime(); } while (0)
#define RACC0() const unsigned long long racc_t0_ = __builtin_amdgcn_s_memrealtime()
#define RACC(i) do { if (F.bid == PROBE_BID && F.tid == 0) ((LAS unsigned long long*)(F.lds + 131072 + 4096))[i] += __builtin_amdgcn_s_memrealtime() - racc_t0_; } while (0)
#else
#define RSTAMP(i)
#define RACC0()
#define RACC(i)
#endif

namespace pg8 {
constexpr int BM = 256, BK = 64, HALF = 128, HTB = HALF * BK * 2, STAGE_BYTES = 8 * HTB, NXCD = 8, WGM = 8;
__host__ __device__ __forceinline__ int lds_byte(int r, int c) { const int st = (r >> 4) * 2 + (c >> 5), rr = r & 15, cc = c & 31, ob = rr * 64 + cc * 2; return st * 1024 + (ob ^ (((ob >> 9) & 1) << 5)); }
__host__ __device__ __forceinline__ void stage_rc(int b, int& R, int& C) { const int st = b / 1024, sb = b % 1024, swz = sb ^ (((sb >> 9) & 1) << 5); R = (st >> 1) * 16 + swz / 64; C = (st & 1) * 32 + (swz % 64) / 2; }
__host__ __device__ __forceinline__ int perm32(int rho) { const int n = rho >> 4, i = rho & 15; return 8 * (i >> 2) + 4 * n + (i & 3); }

struct Unit { int pm, pn, z; size_t aoff, boff; };
struct Gemm { const bf16_t* A; const bf16_t* Bt; int lda, ldb, K; };

struct Sched {
    int mode, nM, nN, nwg, G, c;
    size_t tstepA, tstepB, zstepA, zstepB;
    const LAS int* tile_e;
    __device__ __forceinline__ bool next(int i, Unit& u) const {
        if (mode == 3) { if (i > 0) return false; u.pm = c; u.pn = 0; u.z = 0; u.aoff = (size_t)c * tstepA; u.boff = 0; return true; }
        const long L = (long)i * G + c; if (L >= nwg) return false;
        if (mode == 0) {
            int wgid = (int)L; { const int q = nwg / NXCD, r = nwg % NXCD, xcd = wgid % NXCD, off = wgid / NXCD; wgid = (xcd < r ? xcd * (q + 1) : r * (q + 1) + (xcd - r) * q) + off; }
            const int nig = WGM * nN, gid = wgid / nig, fm = gid * WGM, gsz = (nM - fm) < WGM ? (nM - fm) : WGM;
            u.pm = fm + ((wgid % nig) % gsz); u.pn = (wgid % nig) / gsz; u.z = 0;
            u.aoff = (size_t)u.pm * tstepA; u.boff = (size_t)u.pn * tstepB;
        } else if (mode == 1) {
            const int per = nM * nN, z = (int)L / per, r = (int)L % per;
            u.z = z; u.pm = r % nM; u.pn = r / nM;
            u.aoff = (size_t)z * zstepA + (size_t)u.pm * tstepA; u.boff = (size_t)z * zstepB + (size_t)u.pn * tstepB;
        } else {
            int wgid = (int)L; { const int q = nwg / NXCD, r = nwg % NXCD, xcd = wgid % NXCD, off = wgid / NXCD; wgid = (xcd < r ? xcd * (q + 1) : r * (q + 1) + (xcd - r) * q) + off; }
            const int rt = wgid / nN; u.pn = wgid % nN; u.pm = rt; u.z = tile_e[rt];
            u.aoff = (size_t)rt * tstepA; u.boff = (size_t)u.z * zstepB + (size_t)u.pn * tstepB;
        }
        return true;
    }
};

template <class Epi>
__device__ __forceinline__ void gemm_phase(LAS unsigned char* lds, const Gemm g, const Sched& S, const Epi& E) {
    const int tid = threadIdx.x, wid = __builtin_amdgcn_readfirstlane(tid >> 6), lane = tid & 63, wr = wid >> 2, wc = wid & 3, fr = lane & 15, fq = lane >> 4;
    const int K = g.K, nt = K / BK;
    unsigned voffA[2], voffB[2];
#pragma unroll
    for (int i = 0; i < 2; ++i) { int R, C; stage_rc(tid * 16 + i * 8192, R, C); const int Rb = (R & ~31) + perm32(R & 31);
        voffA[i] = (unsigned)(R * g.lda + C) * 2u; voffB[i] = (unsigned)(Rb * g.ldb + C) * 2u; }
    const size_t kstep = (size_t)(BK * 2);
    const size_t hstepA = (size_t)HALF * g.lda * 2, hstepB = (size_t)HALF * g.ldb * 2;
    const unsigned ldsw = (unsigned)wid * 1024u;
    const int aoff = lds_byte(wr * 64 + fr, fq * 8), boff = lds_byte(wc * 32 + fr, fq * 8);
#define PG8_SA(b, h) (((b) * 2 + (h)) * HTB)
#define PG8_SB(b, h) ((4 + (b) * 2 + (h)) * HTB)
#define PG8_STAGE(bufoff, gbase, voff) do { _Pragma("unroll") for (int _i = 0; _i < 2; ++_i) \
        __builtin_amdgcn_global_load_lds((const unsigned*)((const char*)(gbase) + (voff)[_i]), (LAS unsigned*)(lds + (bufoff) + ldsw + _i * 8192), 16, 0, 0); } while (0)
#define PG8_LDA(dst, b, h) do { _Pragma("unroll") for (int m = 0; m < 4; ++m) _Pragma("unroll") for (int k = 0; k < 2; ++k) dst[m][k] = *(const LAS bf16x8*)(lds + PG8_SA(b, h) + aoff + m * 2048 + k * 1024); } while (0)
#define PG8_LDB(dst, b, h) do { _Pragma("unroll") for (int n = 0; n < 2; ++n) _Pragma("unroll") for (int k = 0; k < 2; ++k) dst[n][k] = *(const LAS bf16x8*)(lds + PG8_SB(b, h) + boff + n * 2048 + k * 1024); } while (0)
#define PG8_MMA(ai, bj, At, Bt) do { __builtin_amdgcn_s_setprio(1); _Pragma("unroll") for (int m = 0; m < 4; ++m) _Pragma("unroll") for (int n = 0; n < 2; ++n) _Pragma("unroll") for (int k = 0; k < 2; ++k) \
        acc[ai][bj][m][n] = __builtin_amdgcn_mfma_f32_16x16x32_bf16(Bt[n][k], At[m][k], acc[ai][bj][m][n], 0, 0, 0); __builtin_amdgcn_s_setprio(0); } while (0)
#define PG8_WAIT_V(n) asm volatile("s_waitcnt vmcnt(" #n ")" ::: "memory")
#define PG8_WAIT_L(n) asm volatile("s_waitcnt lgkmcnt(" #n ")" ::: "memory")
#define PG8_BAR __builtin_amdgcn_s_barrier()
#define PG8_SCHED __builtin_amdgcn_sched_barrier(0)
    Unit cur, nxt; int ui = 0;
    if (!S.next(0, cur)) return;
    f32x4 acc[2][2][4][2];
#pragma unroll
    for (int a = 0; a < 2; ++a)
#pragma unroll
        for (int b = 0; b < 2; ++b)
#pragma unroll
            for (int m = 0; m < 4; ++m)
#pragma unroll
                for (int n = 0; n < 2; ++n) acc[a][b][m][n] = (f32x4){0.f, 0.f, 0.f, 0.f};
    bf16x8 At[4][2], B0[2][2], B1[2][2];
    const char* cA = (const char*)g.A + cur.aoff; const char* cB = (const char*)g.Bt + cur.boff;
    PG8_STAGE(PG8_SB(0, 0), cB, voffB); PG8_STAGE(PG8_SB(0, 1), cB + hstepB, voffB); PG8_STAGE(PG8_SA(0, 0), cA, voffA); PG8_STAGE(PG8_SA(0, 1), cA + hstepA, voffA);
    if (wr == 1) PG8_BAR;
    PG8_WAIT_V(2); PG8_BAR;
    PG8_STAGE(PG8_SB(1, 0), cB + kstep, voffB); PG8_STAGE(PG8_SA(1, 0), cA + kstep, voffA); PG8_STAGE(PG8_SB(1, 1), cB + hstepB + kstep, voffB);
    PG8_WAIT_V(6); PG8_BAR;
    for (;;) {
        const bool has_next = S.next(ui + 1, nxt);
        const char* nA = has_next ? (const char*)g.A + nxt.aoff : cA; const char* nB = has_next ? (const char*)g.Bt + nxt.boff : cB;
        for (int t = 0; t < nt; t += 2) {
            const bool last = (t == nt - 2);
            const char* a1 = cA + (size_t)(t + 1) * kstep;
            const char* a2 = last ? nA : cA + (size_t)(t + 2) * kstep; const char* b2 = last ? nB : cB + (size_t)(t + 2) * kstep;
            const char* a3 = a2 + kstep; const char* b3 = b2 + kstep;
            PG8_LDB(B0, 0, 0); PG8_LDB(B1, 0, 1); PG8_SCHED; PG8_LDA(At, 0, 0); PG8_STAGE(PG8_SA(1, 1), a1 + hstepA, voffA);
            PG8_WAIT_V(8); PG8_WAIT_L(0); PG8_BAR; PG8_MMA(0, 0, At, B0); PG8_MMA(0, 1, At, B1); PG8_BAR; PG8_SCHED;
            PG8_LDA(At, 0, 1); PG8_STAGE(PG8_SB(0, 0), b2, voffB); PG8_STAGE(PG8_SB(0, 1), b2 + hstepB, voffB); PG8_STAGE(PG8_SA(0, 0), a2, voffA);
            PG8_WAIT_V(8); PG8_WAIT_L(0); PG8_BAR; PG8_MMA(1, 0, At, B0); PG8_MMA(1, 1, At, B1); PG8_BAR; PG8_SCHED;
            PG8_LDB(B0, 1, 0); PG8_LDB(B1, 1, 1); PG8_SCHED; PG8_LDA(At, 1, 0); PG8_STAGE(PG8_SA(0, 1), a2 + hstepA, voffA);
            PG8_WAIT_V(8); PG8_WAIT_L(0); PG8_BAR; PG8_MMA(0, 0, At, B0); PG8_MMA(0, 1, At, B1); PG8_BAR; PG8_SCHED;
            PG8_LDA(At, 1, 1); PG8_STAGE(PG8_SB(1, 0), b3, voffB); PG8_STAGE(PG8_SB(1, 1), b3 + hstepB, voffB); PG8_STAGE(PG8_SA(1, 0), a3, voffA);
            PG8_WAIT_V(8); PG8_WAIT_L(0); PG8_BAR; PG8_MMA(1, 0, At, B0); PG8_MMA(1, 1, At, B1); PG8_BAR; PG8_SCHED;
        }
        if (wr == 0) PG8_BAR;
        E(acc, cur, wr, wc, fr, fq);
        if (!has_next) break;
#pragma unroll
        for (int a = 0; a < 2; ++a)
#pragma unroll
            for (int b = 0; b < 2; ++b)
#pragma unroll
                for (int m = 0; m < 4; ++m)
#pragma unroll
                    for (int n = 0; n < 2; ++n) acc[a][b][m][n] = (f32x4){0.f, 0.f, 0.f, 0.f};
        cur = nxt; cA = nA; cB = nB; ++ui;
        if (wr == 1) PG8_BAR;
    }
    PG8_WAIT_V(0);
    PG8_BAR;
#undef PG8_SA
#undef PG8_SB
#undef PG8_STAGE
#undef PG8_LDA
#undef PG8_LDB
#undef PG8_MMA
#undef PG8_WAIT_V
#undef PG8_WAIT_L
#undef PG8_BAR
#undef PG8_SCHED
}
}
using pg8::Unit;

#define EPI_LOOP_BEGIN \
    _Pragma("unroll") for (int ai = 0; ai < 2; ++ai) _Pragma("unroll") for (int m = 0; m < 4; ++m) { const int row = u.pm * 256 + ai * 128 + wr * 64 + m * 16 + fr; (void)row;
#define EPI_LOOP_END }
__device__ __forceinline__ u32x4 pack8(f32x4 v0, f32x4 v1) { u32x4 w; w.x = cvt_pk_bf16(v0[0], v0[1]); w.y = cvt_pk_bf16(v0[2], v0[3]); w.z = cvt_pk_bf16(v1[0], v1[1]); w.w = cvt_pk_bf16(v1[2], v1[3]); return w; }

struct EpiPlain {
    bf16_t* O; int ldc; size_t zstride;
    __device__ __forceinline__ void operator()(const f32x4 (&acc)[2][2][4][2], const Unit& u, int wr, int wc, int fr, int fq) const {
        bf16_t* base = O + (size_t)u.z * zstride; const int col0 = u.pn * 256 + wc * 32 + 8 * fq;
        EPI_LOOP_BEGIN
#pragma unroll
            for (int bj = 0; bj < 2; ++bj) *(u32x4*)(base + (size_t)row * ldc + col0 + bj * 128) = pack8(acc[ai][bj][m][0], acc[ai][bj][m][1]);
        EPI_LOOP_END
    }
};
struct EpiInProj {
    bf16_t *Q, *MID, *UG, *GATES; const float* b_gate;
    __device__ __forceinline__ void operator()(const f32x4 (&acc)[2][2][4][2], const Unit& u, int wr, int wc, int fr, int fq) const {
        const int cb = u.pn * 256, cl = wc * 32 + 8 * fq;
        if (cb < 1024) {
            bf16_t* base = cb < 512 ? Q : MID; const int col0 = (cb & 511) + cl;
            EPI_LOOP_BEGIN
#pragma unroll
                for (int bj = 0; bj < 2; ++bj) *(u32x4*)(base + (size_t)row * 512 + col0 + bj * 128) = pack8(acc[ai][bj][m][0], acc[ai][bj][m][1]);
            EPI_LOOP_END
        } else if (cb < 1536) {
            EPI_LOOP_BEGIN
#pragma unroll
                for (int bj = 0; bj < 2; ++bj) { const int col = cb - 1024 + cl + bj * 128, gidx = col >> 4, q0 = col & 15;
                    *(u32x4*)(UG + ((size_t)gidx * 1024 + (row >> 6)) * UGP + (row & 63) * 16 + q0) = pack8(acc[ai][bj][m][0], acc[ai][bj][m][1]); }
            EPI_LOOP_END
        } else {
            const int col0 = cb - 1536 + cl;
            f32x4 bv[2][2];
#pragma unroll
            for (int bj = 0; bj < 2; ++bj)
#pragma unroll
                for (int n = 0; n < 2; ++n) bv[bj][n] = *(const f32x4*)(b_gate + col0 + bj * 128 + 4 * n);
            EPI_LOOP_BEGIN
#pragma unroll
                for (int bj = 0; bj < 2; ++bj) { f32x4 v0 = acc[ai][bj][m][0] + bv[bj][0], v1 = acc[ai][bj][m][1] + bv[bj][1];
#pragma unroll
                    for (int e = 0; e < 4; ++e) { v0[e] = sigmoidf_(v0[e]); v1[e] = sigmoidf_(v1[e]); }
                    *(u32x4*)(GATES + (size_t)row * 2048 + col0 + bj * 128) = pack8(v0, v1); }
            EPI_LOOP_END
        }
    }
};
struct EpiSst {
    float* SST;
    __device__ __forceinline__ void operator()(const f32x4 (&acc)[2][2][4][2], const Unit& u, int wr, int wc, int fr, int fq) const {
        const int col0 = wc * 32 + 8 * fq;
        EPI_LOOP_BEGIN
            float* p = SST + ((size_t)u.z * 1024 + row) * 128 + col0; *(f32x4*)p = acc[ai][0][m][0]; *(f32x4*)(p + 4) = acc[ai][0][m][1];
        EPI_LOOP_END
    }
};
struct EpiS5Out {
    bf16_t* Z;
    __device__ __forceinline__ void operator()(const f32x4 (&acc)[2][2][4][2], const Unit& u, int wr, int wc, int fr, int fq) const {
        EPI_LOOP_BEGIN
#pragma unroll
            for (int bj = 0; bj < 2; ++bj) { const int col = u.pn * 256 + bj * 128 + wc * 32 + 8 * fq, t = col >> 4, p0 = col & 15;
                f32x4 v0 = acc[ai][bj][m][0], v1 = acc[ai][bj][m][1];
#pragma unroll
                for (int e = 0; e < 4; ++e) { v0[e] = gelu_tanh(v0[e]); v1[e] = gelu_tanh(v1[e]); }
                *(u32x4*)(Z + ((size_t)row * 64 + t) * 512 + u.z * 16 + p0) = pack8(v0, v1); }
        EPI_LOOP_END
    }
};
template <int ACT> struct EpiGlu {
    bf16_t* O; int ldc;
    __device__ __forceinline__ void operator()(const f32x4 (&acc)[2][2][4][2], const Unit& u, int wr, int wc, int fr, int fq) const {
        const int col0 = u.pn * 128 + wc * 32 + 8 * fq;
        EPI_LOOP_BEGIN
            f32x4 r0, r1;
#pragma unroll
            for (int e = 0; e < 4; ++e) {
                if (ACT == 0) { r0[e] = acc[ai][0][m][0][e] * sigmoidf_(acc[ai][1][m][0][e]); r1[e] = acc[ai][0][m][1][e] * sigmoidf_(acc[ai][1][m][1][e]); }
                else { const float g0 = acc[ai][0][m][0][e], g1 = acc[ai][0][m][1][e]; r0[e] = g0 * sigmoidf_(g0) * acc[ai][1][m][0][e]; r1[e] = g1 * sigmoidf_(g1) * acc[ai][1][m][1][e]; } }
            *(u32x4*)(O + (size_t)row * ldc + col0) = pack8(r0, r1);
        EPI_LOOP_END
    }
};
struct EpiGateMul {
    bf16_t* O; const bf16_t* GATES; int goff; const bf16_t* prev;
    __device__ __forceinline__ void operator()(const f32x4 (&acc)[2][2][4][2], const Unit& u, int wr, int wc, int fr, int fq) const {
        const int col0 = u.pn * 256 + wc * 32 + 8 * fq;
#pragma unroll
        for (int ai = 0; ai < 2; ++ai) {
            u32x4 gw[4][2], pw[4][2];
#pragma unroll
            for (int m = 0; m < 4; ++m)
#pragma unroll
                for (int bj = 0; bj < 2; ++bj) { const int row = u.pm * 256 + ai * 128 + wr * 64 + m * 16 + fr, col = col0 + bj * 128;
                    gw[m][bj] = *(const u32x4*)(GATES + (size_t)row * 2048 + goff + col);
                    pw[m][bj] = prev ? *(const u32x4*)(prev + (size_t)row * 1024 + col) : (u32x4){0u, 0u, 0u, 0u}; }
#pragma unroll
            for (int m = 0; m < 4; ++m)
#pragma unroll
                for (int bj = 0; bj < 2; ++bj) { const int row = u.pm * 256 + ai * 128 + wr * 64 + m * 16 + fr, col = col0 + bj * 128;
                    f32x4 v0 = acc[ai][bj][m][0], v1 = acc[ai][bj][m][1]; const u32x4 g4 = gw[m][bj], p4 = pw[m][bj];
                    v0[0] = v0[0] * bflo(g4.x) + bflo(p4.x); v0[1] = v0[1] * bfhi(g4.x) + bfhi(p4.x); v0[2] = v0[2] * bflo(g4.y) + bflo(p4.y); v0[3] = v0[3] * bfhi(g4.y) + bfhi(p4.y);
                    v1[0] = v1[0] * bflo(g4.z) + bflo(p4.z); v1[1] = v1[1] * bfhi(g4.z) + bfhi(p4.z); v1[2] = v1[2] * bflo(g4.w) + bflo(p4.w); v1[3] = v1[3] * bfhi(g4.w) + bfhi(p4.w);
                    *(u32x4*)(O + (size_t)row * 1024 + col) = pack8(v0, v1); }
        }
    }
};
struct EpiRouter {
    float* LOG;
    __device__ __forceinline__ void operator()(const f32x4 (&acc)[2][2][4][2], const Unit& u, int wr, int wc, int fr, int fq) const {
        if (wc == 0 || (wc == 1 && fq == 0)) { const int col0 = wc * 32 + 8 * fq;
            EPI_LOOP_BEGIN
                float* o = LOG + (size_t)row * 64 + col0; *(f32x4*)o = acc[ai][0][m][0] + acc[ai][1][m][0]; *(f32x4*)(o + 4) = acc[ai][0][m][1] + acc[ai][1][m][1];
            EPI_LOOP_END }
    }
};
struct EpiResid {
    const float* X; float* O;
    __device__ __forceinline__ void operator()(const f32x4 (&acc)[2][2][4][2], const Unit& u, int wr, int wc, int fr, int fq) const {
        const int col0 = u.pn * 256 + wc * 32 + 8 * fq;
#pragma unroll
        for (int ai = 0; ai < 2; ++ai) {
            f32x4 xv[4][2][2];
#pragma unroll
            for (int m = 0; m < 4; ++m)
#pragma unroll
                for (int bj = 0; bj < 2; ++bj) { const size_t off = (size_t)(u.pm * 256 + ai * 128 + wr * 64 + m * 16 + fr) * 1024 + col0 + bj * 128;
                    xv[m][bj][0] = *(const f32x4*)(X + off); xv[m][bj][1] = *(const f32x4*)(X + off + 4); }
#pragma unroll
            for (int m = 0; m < 4; ++m)
#pragma unroll
                for (int bj = 0; bj < 2; ++bj) { const size_t off = (size_t)(u.pm * 256 + ai * 128 + wr * 64 + m * 16 + fr) * 1024 + col0 + bj * 128;
                    *(f32x4*)(O + off) = xv[m][bj][0] + acc[ai][bj][m][0]; *(f32x4*)(O + off + 4) = xv[m][bj][1] + acc[ai][bj][m][1]; }
        }
    }
};

struct Frame {
    LAS unsigned char* lds;
    int tid, lane, wave, G, bid, gw, NGW;
    unsigned char* ws;
};

__device__ __forceinline__ pg8::Sched sched_dense(const Frame& F, int Mrows, int N, int lda, int ldb) {
    pg8::Sched S; S.mode = 0; S.nM = Mrows / 256; S.nN = N / 256; S.nwg = S.nM * S.nN; S.G = F.G; S.c = F.bid;
    S.tstepA = (size_t)256 * lda * 2; S.tstepB = (size_t)256 * ldb * 2; S.zstepA = 0; S.zstepB = 0; S.tile_e = nullptr; return S;
}
__device__ __forceinline__ pg8::Sched sched_batch(const Frame& F, int nZ, int nM, int nN, int lda, int ldb, size_t zA, size_t zB) {
    pg8::Sched S; S.mode = 1; S.nM = nM; S.nN = nN; S.nwg = nZ * nM * nN; S.G = F.G; S.c = F.bid;
    S.tstepA = (size_t)256 * lda * 2; S.tstepB = (size_t)256 * ldb * 2; S.zstepA = zA; S.zstepB = zB; S.tile_e = nullptr; return S;
}

__device__ __forceinline__ int dest_row(int mode, int n) {
    if (mode == 0) return n;
    if (mode == 1) return n < 964 ? n : n + 60;
    if (mode == 2) { const int j = n & 511, sel = n >> 9; return 256 * (j >> 7) + 128 * sel + (j & 127); }
    return 256 * (n >> 7) + 128 * (mode - 3) + (n & 127);
}
struct TrItem { const float* W; bf16_t* WT; int K, N, mode, k0, n0; };
__device__ __forceinline__ void transpose_load(const TrItem& t, f32x4 (&v)[8], int lane) {
    const int n = t.n0 + 4 * (lane & 7);
#pragma unroll
    for (int i = 0; i < 8; ++i) { const int kk = 8 * i + (lane >> 3); v[i] = n < t.N ? __builtin_nontemporal_load((const f32x4*)(t.W + (size_t)(t.k0 + kk) * t.N + n)) : (f32x4){0.f, 0.f, 0.f, 0.f}; }
}
__device__ __forceinline__ void transpose_store(const TrItem& t, const f32x4 (&v)[8], LAS float* scr, int lane) {
#pragma unroll
    for (int i = 0; i < 8; ++i) { LAS float* d = scr + (8 * i + (lane >> 3)) * 33 + 4 * (lane & 7); d[0] = v[i].x; d[1] = v[i].y; d[2] = v[i].z; d[3] = v[i].w; }
    LDS_WAIT();
    const int c = lane & 7;
#pragma unroll
    for (int j = 0; j < 4; ++j) { const int nl = (lane >> 3) + 8 * j, n = t.n0 + nl; const LAS float* s = scr + (8 * c) * 33 + nl;
        u32x4 o; o.x = cvt_pk_bf16(s[0 * 33], s[1 * 33]); o.y = cvt_pk_bf16(s[2 * 33], s[3 * 33]); o.z = cvt_pk_bf16(s[4 * 33], s[5 * 33]); o.w = cvt_pk_bf16(s[6 * 33], s[7 * 33]);
        if (n < t.N) *(u32x4*)(t.WT + (size_t)dest_row(t.mode, n) * t.K + t.k0 + 8 * c) = o; }
    LDS_WAIT();
}
__device__ __forceinline__ void rms_row_to_bf16(const float* xrow, const float* gain, bf16_t* orow, int lane) {
    f32x4 v[4]; float s = 0.f;
#pragma unroll
    for (int j = 0; j < 4; ++j) { v[j] = *(const f32x4*)(xrow + 256 * j + 4 * lane); s += (v[j].x * v[j].x + v[j].y * v[j].y) + (v[j].z * v[j].z + v[j].w * v[j].w); }
    const float rstd = 1.0f / sqrtf(wave_sum(s) * (1.0f / 1024.0f) + EPS);
#pragma unroll
    for (int j = 0; j < 4; ++j) { const f32x4 gg = *(const f32x4*)(gain + 256 * j + 4 * lane);
        u32x2 o; o.x = cvt_pk_bf16(v[j].x * rstd * gg.x, v[j].y * rstd * gg.y); o.y = cvt_pk_bf16(v[j].z * rstd * gg.z, v[j].w * rstd * gg.w);
        *(u32x2*)(orow + 256 * j + 4 * lane) = o; }
}

__device__ __forceinline__ void s5_item(const Frame& F, const Params& p, int item) {
    const int g = item / 65, d = item % 65, tid = F.tid;
    LAS float* L = (LAS float*)F.lds;
    LAS float* pwr = L;
    LAS float* pwi = L + 64;
    LAS float* bbr = L + 128;
    LAS float* bbi = L + 128 + 1024;
    LAS float* ccr = L + 128 + 2048;
    LAS float* cci = L + 128 + 3072;
    LAS float* ffr = L + 128 + 4096;
    LAS float* ffi = L + 128 + 4096 + 64;
    const float* a_re = INP(7); const float* a_im = INP(8); const float* log_dt = INP(9);
    const float* b_re = INP(10); const float* b_im = INP(11); const float* c_re = INP(12); const float* c_im = INP(13); const float* d_skip = INP(14);
    if (tid < 64) {
        const int n = tid; const double dt = exp((double)log_dt[g]); const double ar = a_re[g * 64 + n], ai = a_im[g * 64 + n];
        const double mag = exp(ar * dt), abr = mag * cos(ai * dt), abi = mag * sin(ai * dt);
        const double nr = abr - 1.0, ni = abi, den = ar * ar + ai * ai;
        ffr[n] = (float)((nr * ar + ni * ai) / den); ffi[n] = (float)((ni * ar - nr * ai) / den);
        const double mg = exp(ar * dt * d); pwr[n] = (float)(mg * cos(ai * dt * d)); pwi[n] = (float)(mg * sin(ai * dt * d));
    }
    __syncthreads();
    for (int e = tid; e < 1024; e += NT) { const int n = e >> 4; const float br = b_re[g * 1024 + e], bi = b_im[g * 1024 + e], fr_ = ffr[n], fi_ = ffi[n];
        bbr[e] = fr_ * br - fi_ * bi; bbi[e] = fr_ * bi + fi_ * br; ccr[e] = c_re[g * 1024 + e]; cci[e] = c_im[g * 1024 + e]; }
    __syncthreads();
    if (d < 64) {
        if (tid < 256) { const int pp = tid >> 4, q = tid & 15; float k = 0.f;
            for (int n = 0; n < 64; ++n) { const float cr = ccr[pp * 64 + n], ci = cci[pp * 64 + n], wr_ = pwr[n], wi_ = pwi[n];
                const float tr = cr * wr_ - ci * wi_, ti = cr * wi_ + ci * wr_; k += tr * bbr[n * 16 + q] - ti * bbi[n * 16 + q]; }
            if (d == 0 && pp == q) k += d_skip[g * 16 + pp];
            ((float*)(F.ws + WS_KBUF))[((size_t)(g * 64 + d) * 16 + pp) * 16 + q] = k; }
        { const int s = 63 - d, np = tid >> 2, n = np & 63, part = np >> 6, q0 = (tid & 3) * 4; float v[4];
#pragma unroll
          for (int j = 0; j < 4; ++j) { const float br = bbr[n * 16 + q0 + j], bi = bbi[n * 16 + q0 + j]; v[j] = part ? (pwr[n] * bi + pwi[n] * br) : (pwr[n] * br - pwi[n] * bi); }
          u32x2 o; o.x = cvt_pk_bf16(v[0], v[1]); o.y = cvt_pk_bf16(v[2], v[3]);
          *(u32x2*)((bf16_t*)(F.ws + WS_WST) + ((size_t)g * 256 + np) * 1024 + s * 16 + q0) = o; }
    }
    if (d >= 1) { const int t = d - 1, pp = tid >> 5, np0 = (tid & 31) * 4; float v[4];
#pragma unroll
        for (int j = 0; j < 4; ++j) { const int np = np0 + j, n = np & 63, part = np >> 6; const float cr = ccr[pp * 64 + n], ci = cci[pp * 64 + n];
            v[j] = part ? -(cr * pwi[n] + ci * pwr[n]) : (cr * pwr[n] - ci * pwi[n]); }
        u32x2 o; o.x = cvt_pk_bf16(v[0], v[1]); o.y = cvt_pk_bf16(v[2], v[3]);
        *(u32x2*)((bf16_t*)(F.ws + WS_TT) + ((size_t)g * 1024 + t * 16 + pp) * UGP + 1024 + np0) = o; }
    if (d == 64 && tid < 64) { float* a64 = (float*)(F.ws + WS_CTL + 1024); a64[(g * 64 + tid) * 2] = pwr[tid]; a64[(g * 64 + tid) * 2 + 1] = pwi[tid]; }
    __syncthreads();
}

__device__ __forceinline__ void phase0(const Frame& F, const Params& p) {
    unsigned char* ws = F.ws;
    if (F.bid == 0 && F.tid < 80) ((int*)(ws + WS_CTL))[F.tid] = 0;
    if (F.bid == 0 && F.tid < 8) *(unsigned*)(ws + WS_CTL + 40960 + F.tid * 256) = 0u;
    for (int it = F.bid; it < 32 * 65; it += F.G) s5_item(F, p, it);
    RSTAMP(35);
    {
        LAS float* scr = (LAS float*)(F.lds + F.wave * 8704);
        const int I_IN = 16 * 111, I_S = 8 * 32  , I_OUT = 16 * 32, I_E1 = 16 * 16  , I_E2 = 8 * 32  ;
        const int NITEMS = I_IN + 3 * I_S + I_OUT + 32 * (2 * I_E1 + I_E2);
        auto decode = [&](int it) {
            TrItem t; int r = it;
            auto fill = [&](const float* W, int K, int N, bf16_t* WT, int mode, int rr) { const int nblk = (N + 31) / 32; t.W = W; t.WT = WT; t.K = K; t.N = N; t.mode = mode; t.k0 = 64 * (rr / nblk); t.n0 = 32 * (rr % nblk); };
            if (r < I_IN) { fill(INP(2), 1024, 3524, (bf16_t*)(ws + WS_WIN), 1, r); return t; } r -= I_IN;
            if (r < I_S) { fill(INP(16), 512, 1024, (bf16_t*)(ws + WS_WUPA), 0, r); return t; } r -= I_S;
            if (r < I_S) { fill(INP(15), 512, 1024, (bf16_t*)(ws + WS_WGLU), 2, r); return t; } r -= I_S;
            if (r < I_S) { fill(INP(17), 512, 1024, (bf16_t*)(ws + WS_WUPB), 0, r); return t; } r -= I_S;
            if (r < I_OUT) { fill(INP(19), 1024, 1024, (bf16_t*)(ws + WS_WOUT), 0, r); return t; } r -= I_OUT;
            const int per_e = 2 * I_E1 + I_E2, e = r / per_e; r -= e * per_e;
            if (r < I_E1) { fill(INP(25) + (size_t)e * 1024 * 512, 1024, 512, (bf16_t*)(ws + WS_WGU) + (size_t)e * 1024 * 1024, 3, r); return t; } r -= I_E1;
            if (r < I_E1) { fill(INP(26) + (size_t)e * 1024 * 512, 1024, 512, (bf16_t*)(ws + WS_WGU) + (size_t)e * 1024 * 1024, 4, r); return t; } r -= I_E1;
            fill(INP(27) + (size_t)e * 512 * 1024, 512, 1024, (bf16_t*)(ws + WS_WD) + (size_t)e * 1024 * 512, 0, r); return t;
        };
        int it = F.gw;
        if (it < NITEMS) {
            TrItem cur = decode(it); f32x4 v[8]; transpose_load(cur, v, F.lane);
            for (;;) { const int nit = it + F.NGW; const bool more = nit < NITEMS;
                f32x4 vn[8]; const TrItem nx = decode(more ? nit : it); transpose_load(nx, vn, F.lane);
                transpose_store(cur, v, scr, F.lane);
                if (!more) break;
                cur = nx; it = nit;
#pragma unroll
                for (int i = 0; i < 8; ++i) v[i] = vn[i]; }
        }
    }
    RSTAMP(36);
    {
        const long gt = (long)F.bid * NT + F.tid, GT = (long)F.G * NT;
        const u32x4 z4 = (u32x4){0u, 0u, 0u, 0u};
        for (long i = gt; i < 60 * 128; i += GT) *(u32x4*)((bf16_t*)(ws + WS_WIN) + (size_t)(964 + i / 128) * 1024 + (i % 128) * 8) = z4;
        for (long i = gt; i < 32L * 128 * 128; i += GT) { const long g = i / (128 * 128), r = (i / 128) % 128, c = i % 128; *(u32x4*)((bf16_t*)(ws + WS_WST) + ((size_t)g * 256 + 128 + r) * 1024 + c * 8) = z4; }
        const float* w_uk = INP(4); const float* w_uv = INP(5);
        for (long i = gt; i < 1024L * 64; i += GT) { const int row = (int)(i / 64), c8 = (int)(i % 64) * 8, h = row >> 7, r = row & 127, hh = c8 >> 6, d0 = c8 & 63; u32x4 o = z4;
            if (h == hh) { const float* s = w_uk + ((size_t)r * 8 + h) * 64 + d0; const float qs = 0.125f * 1.44269504f;     o.x = cvt_pk_bf16(s[0] * qs, s[1] * qs); o.y = cvt_pk_bf16(s[2] * qs, s[3] * qs); o.z = cvt_pk_bf16(s[4] * qs, s[5] * qs); o.w = cvt_pk_bf16(s[6] * qs, s[7] * qs); }
            *(u32x4*)((bf16_t*)(ws + WS_WQL) + (size_t)row * 512 + c8) = o; }
        for (long i = gt; i < 1024L * 64; i += GT) { const int row = (int)(i / 64), c8 = (int)(i % 64) * 8, h = row >> 7, r = row & 127, hh = c8 >> 6, d0 = c8 & 63; u32x4 o = z4;
            if (h == hh) { const float* s = w_uv + ((size_t)r * 8 + h) * 64 + d0; o.x = cvt_pk_bf16(s[0], s[1]); o.y = cvt_pk_bf16(s[2], s[3]); o.z = cvt_pk_bf16(s[4], s[5]); o.w = cvt_pk_bf16(s[6], s[7]); }
            *(u32x4*)((bf16_t*)(ws + WS_WO) + (size_t)row * 512 + c8) = o; }
    }
    {
        const long gt = (long)F.bid * NT + F.tid, GT = (long)F.G * NT;
        for (long i = gt; i < 256L * 256; i += GT) { const int row = (int)(i >> 8), c8 = (int)(i & 255) * 8, e = row & 127, lo = row >> 7, half = c8 >> 10, d0 = c8 & 1023;
            u32x4 o = (u32x4){0u, 0u, 0u, 0u};
            if (e < 36 && !(lo && half)) { float v[8];
#pragma unroll
                for (int j = 0; j < 8; ++j) { const float w = e < 4 ? INP(21)[(size_t)(d0 + j) * 4 + e] : INP(23)[(size_t)(d0 + j) * 32 + (e - 4)]; const float h = bf2f(f2bf(w)); v[j] = lo ? (w - h) : h; }
                o.x = cvt_pk_bf16(v[0], v[1]); o.y = cvt_pk_bf16(v[2], v[3]); o.z = cvt_pk_bf16(v[4], v[5]); o.w = cvt_pk_bf16(v[6], v[7]); }
            *(u32x4*)((bf16_t*)(ws + WS_WR) + (size_t)row * 2048 + c8) = o; }
    }
    RSTAMP(37);
    { const float* X = INP(0); const float* gain = INP(1); bf16_t* H = (bf16_t*)(ws + WS_H); const int lane = F.lane;
      for (int m0 = F.gw * 4; m0 < MTOK; m0 += F.NGW * 4) {
        f32x4 v[4][4]; float ss[4];
#pragma unroll
        for (int u = 0; u < 4; ++u)
#pragma unroll
            for (int j = 0; j < 4; ++j) v[u][j] = __builtin_nontemporal_load((const f32x4*)(X + (size_t)(m0 + u) * 1024 + 256 * j + 4 * lane));
#pragma unroll
        for (int u = 0; u < 4; ++u) { float s_ = 0.f;
#pragma unroll
            for (int j = 0; j < 4; ++j) s_ += (v[u][j].x * v[u][j].x + v[u][j].y * v[u][j].y) + (v[u][j].z * v[u][j].z + v[u][j].w * v[u][j].w);
            ss[u] = s_; }
#pragma unroll
        for (int o = 1; o < 64; o <<= 1) {
#pragma unroll
            for (int u = 0; u < 4; ++u) ss[u] += __shfl_xor(ss[u], o); }
#pragma unroll
        for (int u = 0; u < 4; ++u) { const float rstd = 1.0f / sqrtf(ss[u] * (1.0f / 1024.0f) + EPS);
#pragma unroll
            for (int j = 0; j < 4; ++j) { const f32x4 gg = *(const f32x4*)(gain + 256 * j + 4 * lane);
                u32x2 o; o.x = cvt_pk_bf16(v[u][j].x * rstd * gg.x, v[u][j].y * rstd * gg.y); o.y = cvt_pk_bf16(v[u][j].z * rstd * gg.z, v[u][j].w * rstd * gg.w);
                *(u32x2*)(H + (size_t)(m0 + u) * 1024 + 256 * j + 4 * lane) = o; } }
      } }
}

__device__ __forceinline__ void expand_tt(const Frame& F) {
    const float* kbuf = (const float*)(F.ws + WS_KBUF); bf16_t* TT = (bf16_t*)(F.ws + WS_TT);
    for (int r0 = F.gw * 4; r0 < 32 * 1024; r0 += F.NGW * 4) { const int s = F.lane;
        f32x4 q[4][4];
#pragma unroll
        for (int u = 0; u < 4; ++u) { const int r = r0 + u, g = r >> 10, t = (r >> 4) & 63, pp = r & 15; const int dd = s <= t ? t - s : 0;
            const float* src = kbuf + ((size_t)(g * 64 + dd) * 16 + pp) * 16;
#pragma unroll
            for (int j = 0; j < 4; ++j) q[u][j] = *(const f32x4*)(src + 4 * j); }
#pragma unroll
        for (int u = 0; u < 4; ++u) { const int r = r0 + u, t = (r >> 4) & 63;
            u32x4 o0 = pack8(q[u][0], q[u][1]), o1 = pack8(q[u][2], q[u][3]);
            if (s > t) { o0 = (u32x4){0u, 0u, 0u, 0u}; o1 = o0; }
            bf16_t* dst = TT + (size_t)r * UGP + s * 16; *(u32x4*)dst = o0; *(u32x4*)(dst + 8) = o1; }
    }
}

__device__ __forceinline__ void phase_cnorm(const Frame& F, const Params& p) {
    const bf16_t* MID = (const bf16_t*)(F.ws + WS_MID); bf16_t* C = (bf16_t*)(F.ws + WS_C);
    const float g0 = INP(3)[2 * F.lane], g1 = INP(3)[2 * F.lane + 1];
    for (int m0 = F.gw * 8; m0 < MTOK; m0 += F.NGW * 8) {
        unsigned wv_[8]; float ss[8];
#pragma unroll
        for (int u = 0; u < 8; ++u) wv_[u] = *(const unsigned*)(MID + (size_t)(m0 + u) * 512 + 2 * F.lane);
#pragma unroll
        for (int u = 0; u < 8; ++u) { const float a = bflo(wv_[u]), b = bfhi(wv_[u]); ss[u] = a * a + b * b; }
#pragma unroll
        for (int o = 1; o < 64; o <<= 1) {
#pragma unroll
            for (int u = 0; u < 8; ++u) ss[u] += __shfl_xor(ss[u], o); }
#pragma unroll
        for (int u = 0; u < 8; ++u) { const float rstd = 1.0f / sqrtf(ss[u] * (1.0f / 128.0f) + EPS);
            *(unsigned*)(C + (size_t)(m0 + u) * 128 + 2 * F.lane) = cvt_pk_bf16(bflo(wv_[u]) * rstd * g0, bfhi(wv_[u]) * rstd * g1); }
    }
}

__device__ __forceinline__ float relu_i(float x) { return __int_as_float(max(__float_as_int(x), 0)); }
__device__ __forceinline__ unsigned f2key(float f) { const unsigned u = __float_as_uint(f + 0.0f);     return u ^ ((unsigned)((int)u >> 31) | 0x80000000u); }
__device__ __forceinline__ float key2f(unsigned k) { return __uint_as_float((k & 0x80000000u) ? (k ^ 0x80000000u) : ~k); }
__device__ __forceinline__ void find_thr(const LAS unsigned* hrow, int rot8, unsigned need, int lane, unsigned& bin, unsigned& above) {
    const int pl = lane; (void)rot8;
    const u32x4 w0 = *(const LAS u32x4*)(hrow + 8 * pl), w1 = *(const LAS u32x4*)(hrow + 8 * pl + 4);
    unsigned w[8] = {w0.x, w0.y, w0.z, w0.w, w1.x, w1.y, w1.z, w1.w};
    unsigned ls = 0;
#pragma unroll
    for (int k = 0; k < 8; ++k) ls += (w[k] & 0xffffu) + (w[k] >> 16);
    unsigned incl = ls;
#pragma unroll
    for (int off = 1; off < 64; off <<= 1) { const unsigned v = __shfl_down(incl, off); if (lane + off < 64) incl += v; }
    const unsigned excl = incl - ls;
    const bool hit = excl < need && incl >= need;
    const unsigned long long mk = __ballot(hit);
    const int src = mk ? (__ffsll((long long)mk) - 1) : 0;
    unsigned cum = excl, b = 16 * lane, ab = excl; bool found = false;
#pragma unroll
    for (int k = 7; k >= 0; --k) {
        unsigned c = w[k] >> 16; if (!found && cum + c >= need) { b = 16 * lane + 2 * k + 1; ab = cum; found = true; } cum += c;
        c = w[k] & 0xffffu;      if (!found && cum + c >= need) { b = 16 * lane + 2 * k; ab = cum; found = true; } cum += c;
    }
    bin = mk ? __shfl(b, src) : 0u; above = __shfl(ab, src);
}

template <int N>
__device__ __forceinline__ void find_thr_n(const LAS unsigned* hrow0, int q0, const unsigned (&need)[N], int lane, unsigned (&bin)[N], unsigned (&above)[N]) {
    unsigned w[N][8], ls[N], incl[N];
#pragma unroll
    for (int i = 0; i < N; ++i) { const int pl = lane; (void)q0; const LAS unsigned* hr = hrow0 + i * 512;
        const u32x4 w0 = *(const LAS u32x4*)(hr + 8 * pl), w1 = *(const LAS u32x4*)(hr + 8 * pl + 4);
        w[i][0] = w0.x; w[i][1] = w0.y; w[i][2] = w0.z; w[i][3] = w0.w; w[i][4] = w1.x; w[i][5] = w1.y; w[i][6] = w1.z; w[i][7] = w1.w; }
#pragma unroll
    for (int i = 0; i < N; ++i) { unsigned t = 0;
#pragma unroll
        for (int k = 0; k < 8; ++k) t += (w[i][k] & 0xffffu) + (w[i][k] >> 16);
        ls[i] = t; incl[i] = t; }
#pragma unroll
    for (int off = 1; off < 64; off <<= 1) {
#pragma unroll
        for (int i = 0; i < N; ++i) { const unsigned v = __shfl_down(incl[i], off); if (lane + off < 64) incl[i] += v; } }
    unsigned b[N], ab[N]; int src[N]; unsigned long long mk[N];
#pragma unroll
    for (int i = 0; i < N; ++i) { const unsigned excl = incl[i] - ls[i]; mk[i] = __ballot(excl < need[i] && incl[i] >= need[i]); src[i] = mk[i] ? (__ffsll((long long)mk[i]) - 1) : 0;
        unsigned cum = excl; b[i] = 16 * lane; ab[i] = excl; bool found = false;
#pragma unroll
        for (int k = 7; k >= 0; --k) {
            unsigned c = w[i][k] >> 16; if (!found && cum + c >= need[i]) { b[i] = 16 * lane + 2 * k + 1; ab[i] = cum; found = true; } cum += c;
            c = w[i][k] & 0xffffu;      if (!found && cum + c >= need[i]) { b[i] = 16 * lane + 2 * k; ab[i] = cum; found = true; } cum += c; } }
#pragma unroll
    for (int i = 0; i < N; ++i) { bin[i] = mk[i] ? __shfl(b[i], src[i]) : 0u; above[i] = __shfl(ab[i], src[i]); }
}
#define TKT0()
#define TKT0R()
#define TKT1(i)
__device__ __forceinline__ void topk_unit_ref(const Frame& F, int b, int ch, unsigned short* IDX) {
    const bf16_t* MID = (const bf16_t*)(F.ws + WS_MID);
    const int lane = F.lane, w = F.wave, r = lane & 31, hi = lane >> 5;
    const int limit = 64 * (ch + 1), tok0 = b * SEQ + 64 * ch;
    LAS unsigned* hist = (LAS unsigned*)(F.lds + w * 16384);
    LAS unsigned short* outl = (LAS unsigned short*)hist;
    if (limit <= 256) {
#pragma unroll
        for (int qq = 0; qq < 8; ++qq) { const int tok = tok0 + 8 * w + qq; u32x2 o; o.x = (4u * lane) | ((4u * lane + 1u) << 16); o.y = (4u * lane + 2u) | ((4u * lane + 3u) << 16);
            *(u32x2*)(IDX + (size_t)tok * 256 + 4 * lane) = o; }
        return;
    }
    bf16x8 a[4];
    { const bf16_t* ap = MID + (size_t)(tok0 + 8 * w + (r >> 2)) * 512 + 128 + (r & 3) * 64 + 8 * hi;
#pragma unroll
      for (int s = 0; s < 4; ++s) a[s] = *(const bf16x8*)(ap + 16 * s); }
    float wv[4][4];
#pragma unroll
    for (int g = 0; g < 4; ++g) { const u32x2 ww = *(const u32x2*)(MID + (size_t)(tok0 + 8 * w + 2 * g + hi) * 512 + 448);
        wv[g][0] = bflo(ww.x) * 0.0625f; wv[g][1] = bfhi(ww.x) * 0.0625f; wv[g][2] = bflo(ww.y) * 0.0625f; wv[g][3] = bfhi(ww.y) * 0.0625f; }
    asm volatile("" :: "v"(a[0]), "v"(a[1]), "v"(a[2]), "v"(a[3]));
    asm volatile("" :: "v"(wv[0][0]), "v"(wv[0][1]), "v"(wv[0][2]), "v"(wv[0][3]), "v"(wv[1][0]), "v"(wv[1][1]), "v"(wv[1][2]), "v"(wv[1][3]),
                       "v"(wv[2][0]), "v"(wv[2][1]), "v"(wv[2][2]), "v"(wv[2][3]), "v"(wv[3][0]), "v"(wv[3][1]), "v"(wv[3][2]), "v"(wv[3][3]));
    unsigned b1[4], ab1[4], Gc[4], Ec[4], cgt[4], ceq[4]; float thA[4], thB[4];
#pragma unroll
    for (int g = 0; g < 4; ++g) { b1[g] = 0; ab1[g] = 0; Gc[g] = 0; Ec[g] = 0; cgt[g] = 0; ceq[g] = 0; thA[g] = -INFINITY; thB[g] = 0.f; }
    const int npair = ch + 1;
    LAS unsigned char* ktl = F.lds + LDS_GEMM + LDS_MISC;
    const bf16_t* gsrc = MID + (size_t)(b * SEQ + (F.tid >> 3)) * 512 + 384 + (F.tid & 7) * 8;
    const unsigned swoff = (unsigned)(F.tid >> 3) * 144u + (unsigned)(F.tid & 7) * 16u, rdoff = (unsigned)r * 144u + (unsigned)hi * 16u;
    const unsigned lm = (1u << r) - 1u;
    const unsigned dummyw = (unsigned)(LDS_GEMM / 4 + w * 64 + lane) - (unsigned)(w * 4096);
    auto run_pass = [&](auto PT_) __attribute__((always_inline)) {
        constexpr int pass = decltype(PT_)::value;
        if (pass < 2) {
#pragma unroll
            for (int i = 0; i < 16; ++i) *(LAS u32x4*)(hist + 4 * lane + 256 * i) = (u32x4){0u, 0u, 0u, 0u};
        }
        LDS_WAIT();
#define KT_PTR(T) (gsrc + (size_t)((T) < npair ? (T) : npair - 1) * 64 * 512)
#define KT_ISSUE(DST, T) asm volatile("global_load_dwordx4 %0, %1, off" : "=v"(DST) : "v"(KT_PTR(T)) : "memory")
#define KT_WAIT(DST, N) asm volatile("s_waitcnt vmcnt(" #N ")" : "+v"(DST) :: "memory")
#define TK_SCORE4(AC, KT) do { float sc[4]; \
        _Pragma("unroll") for (int g = 0; g < 4; ++g) { \
            const float r0 = relu_i(AC[4 * g]), r1 = relu_i(AC[4 * g + 1]), r2 = relu_i(AC[4 * g + 2]), r3 = relu_i(AC[4 * g + 3]); \
            sc[g] = __fmaf_rn(wv[g][3], r3, __fmaf_rn(wv[g][2], r2, __fmaf_rn(wv[g][1], r1, __fmul_rn(wv[g][0], r0)))); } \
        if (pass < 2) {     \
            unsigned wa[4], inc[4]; \
            _Pragma("unroll") for (int g = 0; g < 4; ++g) { \
                const bool c = pass == 0 ? (sc[g] >= thA[g]) : ((sc[g] >= thA[g]) & (sc[g] < thB[g])); \
                const unsigned key = f2key(sc[g]), bin = pass == 0 ? (key >> 22) : ((key >> 12) & 1023u); \
                const unsigned real = (unsigned)(2 * g + hi) * 512u + (bin >> 1); \
                wa[g] = c ? real : dummyw; inc[g] = c ? (1u << (16 * (bin & 1u))) : 0u; } \
            _Pragma("unroll") for (int g = 0; g < 4; ++g) (void)__hip_atomic_fetch_add(hist + wa[g], inc[g], __ATOMIC_RELAXED, __HIP_MEMORY_SCOPE_WORKGROUP); \
        } else {     \
            unsigned long long mge[4], mgt[4]; unsigned long long anyeq = 0ull; bool gtb[4]; \
            _Pragma("unroll") for (int g = 0; g < 4; ++g) { gtb[g] = sc[g] >= thB[g]; mge[g] = __ballot(sc[g] >= thA[g]); mgt[g] = __ballot(gtb[g]); anyeq |= mge[g] & ~mgt[g]; } \
            const unsigned short kidx = (unsigned short)((KT) * 32 + r); \
            unsigned pos[4]; \
            _Pragma("unroll") for (int g = 0; g < 4; ++g) { const unsigned myg = hi ? (unsigned)(mgt[g] >> 32) : (unsigned)mgt[g]; pos[g] = cgt[g] + __popc(myg & lm); cgt[g] += __popc(myg); } \
            _Pragma("unroll") for (int g = 0; g < 4; ++g) if (gtb[g] & (pos[g] < 256u)) outl[(2 * g + hi) * 256 + pos[g]] = kidx; \
            if (anyeq) { \
                _Pragma("unroll") for (int g = 0; g < 4; ++g) { const unsigned long long me = mge[g] & ~mgt[g]; \
                    if (me) { const unsigned mye = hi ? (unsigned)(me >> 32) : (unsigned)me; const bool eq = (sc[g] >= thA[g]) & !gtb[g]; \
                        if (eq) { const unsigned rk = ceq[g] + __popc(mye & lm); if (rk < Ec[g]) { const unsigned ps = Gc[g] + rk; if (ps < 256u) outl[(2 * g + hi) * 256 + ps] = kidx; } } \
                        ceq[g] += __popc(mye); } } } } } while (0)
#define TK_LB(J) do { if (pass == 0 && ((J) == 7 || (J) == 31) && (J) + 1 < npair) { LDS_WAIT(); \
        _Pragma("unroll") for (int qq = 0; qq < 8; ++qq) { unsigned bin, above; find_thr(hist + qq * 512, qq >> 1, 256u, lane, bin, above); if ((qq & 1) == hi && bin >= 2u) thA[qq >> 1] = key2f(bin << 22); } } } while (0)
        u32x4 g0, g1, gqA, gqB, gqC, gqD;
        KT_ISSUE(g0, 0); KT_ISSUE(g1, 1); KT_ISSUE(gqA, 2); KT_ISSUE(gqB, 3); KT_ISSUE(gqC, 4); KT_ISSUE(gqD, 5);
        asm volatile("s_waitcnt vmcnt(4)" : "+v"(g0), "+v"(g1) :: "memory");
        *(LAS u32x4*)(ktl + swoff) = g0; *(LAS u32x4*)(ktl + 9216 + swoff) = g1;
        __syncthreads();
        bf16x8 bkX[4], bkY[4];
#pragma unroll
        for (int s = 0; s < 4; ++s) { bkX[s] = *(const LAS bf16x8*)(ktl + rdoff + s * 32); bkY[s] = bkX[s]; }
        f32x16 accX, accY;
#pragma unroll
        for (int i = 0; i < 16; ++i) { accX[i] = 0.f; accY[i] = 0.f; }
        int bc = 0, bn = 1, bs = 2;
#define TK_STEP(BKC, BKN, ACCC, ACCP, KT, NXP) { \
            _Pragma("unroll") for (int i = 0; i < 16; ++i) ACCC[i] = 0.f; \
            _Pragma("unroll") for (int s = 0; s < 4; ++s) ACCC = __builtin_amdgcn_mfma_f32_32x32x16_bf16(a[s], BKC[s], ACCC, 0, 0, 0); \
            _Pragma("unroll") for (int s = 0; s < 4; ++s) BKN[s] = *(const LAS bf16x8*)((NXP) + s * 32); \
            if ((KT) > 0) TK_SCORE4(ACCP, (KT) - 1); }
#define TK_ROUND(GQ) { \
            TK_STEP(bkX, bkY, accX, accY, 2 * it, ktl + bc * 9216 + rdoff + 32 * 144) \
            if (it > 0) TK_LB(it - 1); \
            TK_STEP(bkY, bkX, accY, accX, 2 * it + 1, ktl + bn * 9216 + rdoff) \
            KT_WAIT(GQ, 3); \
            *(LAS u32x4*)(ktl + bs * 9216 + swoff) = GQ; \
            KT_ISSUE(GQ, it + 6); \
            { const int t_ = bc; bc = bn; bn = bs; bs = t_; } \
            __syncthreads(); }
#pragma unroll 1
        for (int it0 = 0; it0 < npair; it0 += 4) {
            { const int it = it0;     if (it < npair) TK_ROUND(gqA) }
            { const int it = it0 + 1; if (it < npair) TK_ROUND(gqB) }
            { const int it = it0 + 2; if (it < npair) TK_ROUND(gqC) }
            { const int it = it0 + 3; if (it < npair) TK_ROUND(gqD) }
        }
        asm volatile("s_waitcnt vmcnt(0)" : "+v"(gqA), "+v"(gqB), "+v"(gqC), "+v"(gqD) :: "memory");
        TK_SCORE4(accY, 2 * npair - 1);
        TKT1(40 + pass);
#undef TK_STEP
#undef TK_SCORE4
#undef TK_ROUND
#undef TK_LB
#undef KT_PTR
#undef KT_ISSUE
#undef KT_WAIT
        LDS_WAIT();
        TKT0R();
        if (pass == 0) {
#pragma unroll
            for (int h4 = 0; h4 < 2; ++h4) { const unsigned nd[4] = {256u, 256u, 256u, 256u}; unsigned bn4[4], ab4[4]; find_thr_n<4>(hist + h4 * 4 * 512, h4 * 4, nd, lane, bn4, ab4);
#pragma unroll
                for (int i = 0; i < 4; ++i) { const int qq = h4 * 4 + i; if ((qq & 1) == hi) { b1[qq >> 1] = bn4[i]; ab1[qq >> 1] = ab4[i]; thA[qq >> 1] = key2f(bn4[i] << 22); thB[qq >> 1] = key2f((bn4[i] + 1u) << 22); } } }
        } else if (pass == 1) {
#pragma unroll
            for (int h4 = 0; h4 < 2; ++h4) { unsigned nd[4], bn4[4], ab4[4];
#pragma unroll
                for (int i = 0; i < 4; ++i) { const int qq = h4 * 4 + i; nd[i] = 256u - __shfl(ab1[qq >> 1], (qq & 1) * 32); }
                find_thr_n<4>(hist + h4 * 4 * 512, h4 * 4, nd, lane, bn4, ab4);
#pragma unroll
                for (int i = 0; i < 4; ++i) { const int qq = h4 * 4 + i; if ((qq & 1) == hi) { const unsigned t20 = (b1[qq >> 1] << 10) | bn4[i]; thA[qq >> 1] = key2f(t20 << 12); thB[qq >> 1] = key2f((t20 + 1u) << 12); Gc[qq >> 1] = ab1[qq >> 1] + ab4[i]; Ec[qq >> 1] = 256u - (ab1[qq >> 1] + ab4[i]); } } }
        }
        LDS_WAIT();
        TKT1(43);
    };
    run_pass(std::integral_constant<int, 0>{}); run_pass(std::integral_constant<int, 1>{}); run_pass(std::integral_constant<int, 2>{});
#pragma unroll
    for (int qq = 0; qq < 8; ++qq) { const int tok = tok0 + 8 * w + qq;
        if (lane < 32) *(u32x4*)(IDX + (size_t)tok * 256 + lane * 8) = *(const LAS u32x4*)(outl + qq * 256 + lane * 8); }
    LDS_WAIT();
}
__device__ __forceinline__ unsigned mbcnt64(unsigned long long m) { return __builtin_amdgcn_mbcnt_hi((unsigned)(m >> 32), __builtin_amdgcn_mbcnt_lo((unsigned)m, 0u)); }
__device__ __forceinline__ int tk_bin(float s, int ebase) {
    const unsigned u = __float_as_uint(s + 0.0f); const int c = (int)((u & 0x7fffffffu) >> 18), sg = (int)u >> 31;
    const int d = c - ebase;
    const int t = 32 - ((ebase + 39 - c) >> 3);
    const int cc = max(max(d, t), 0);
    return min(max(512 + (cc ^ sg), 0), 1023);
}
__device__ __forceinline__ float tk_edge(int b, int ebase) {
    if (b <= 0) return -INFINITY;
    if (b >= 1024) return INFINITY;
    if (b >= 513) { const int m = b - 512; const int c = m >= 33 ? m + ebase : ebase + 40 - ((33 - m) << 3); return c <= 0 ? 0.0f : (c >= (255 << 5) ? INFINITY : __uint_as_float((unsigned)c << 18)); }
    if (b == 512) return 0.0f;
    { const int m = 512 - b; const int c = m >= 33 ? m + ebase : ebase + 40 - ((33 - m) << 3);
      if (c <= 0) return -0.0f; if (c >= (255 << 5)) return -INFINITY;
      return __uint_as_float((0x80000000u | ((unsigned)c << 18)) - 1u); }
}
template <int N>
__device__ __forceinline__ void find_thr_c(const LAS unsigned* hrow0, const unsigned (&need)[N], int lane, unsigned (&bin)[N], unsigned (&above)[N], unsigned (&cntb)[N]) {
    unsigned w[N][8], ls[N], incl[N];
#pragma unroll
    for (int i = 0; i < N; ++i) { const LAS unsigned* hr = hrow0 + i * 512;
        const u32x4 w0 = *(const LAS u32x4*)(hr + 8 * lane), w1 = *(const LAS u32x4*)(hr + 8 * lane + 4);
        w[i][0] = w0.x; w[i][1] = w0.y; w[i][2] = w0.z; w[i][3] = w0.w; w[i][4] = w1.x; w[i][5] = w1.y; w[i][6] = w1.z; w[i][7] = w1.w; }
#pragma unroll
    for (int i = 0; i < N; ++i) { unsigned t = 0;
#pragma unroll
        for (int k = 0; k < 8; ++k) t += (w[i][k] & 0xffffu) + (w[i][k] >> 16);
        ls[i] = t; incl[i] = t; }
#pragma unroll
    for (int off = 1; off < 64; off <<= 1) {
#pragma unroll
        for (int i = 0; i < N; ++i) { const unsigned v = __shfl_down(incl[i], off); if (lane + off < 64) incl[i] += v; } }
    unsigned bb[N], ab[N], cb[N]; int src[N]; unsigned long long mk[N];
#pragma unroll
    for (int i = 0; i < N; ++i) { const unsigned excl = incl[i] - ls[i]; mk[i] = __ballot(excl < need[i] && incl[i] >= need[i]); src[i] = mk[i] ? (__ffsll((long long)mk[i]) - 1) : 0;
        unsigned cum = excl; bb[i] = 16 * lane; ab[i] = excl; cb[i] = 0; bool found = false;
#pragma unroll
        for (int k = 7; k >= 0; --k) {
            unsigned c = w[i][k] >> 16; if (!found && cum + c >= need[i]) { bb[i] = 16 * lane + 2 * k + 1; ab[i] = cum; cb[i] = c; found = true; } cum += c;
            c = w[i][k] & 0xffffu;      if (!found && cum + c >= need[i]) { bb[i] = 16 * lane + 2 * k; ab[i] = cum; cb[i] = c; found = true; } cum += c; } }
#pragma unroll
    for (int i = 0; i < N; ++i) { bin[i] = mk[i] ? __shfl(bb[i], src[i]) : 0u; above[i] = __shfl(ab[i], src[i]); cntb[i] = __shfl(cb[i], src[i]); }
}
__device__ __forceinline__ int tk_xbin(float s) {
    const unsigned u = __float_as_uint(s + 0.0f); const int c = (int)((u >> 18) & 0x1fffu), c3 = (int)((u >> 21) & 0x3ffu);
    const int m = max(max(c - 3616, c3 - 424), 0);
    return min(max(m ^ ((int)u >> 31), -512), 511);
}
__device__ __forceinline__ void topk_unit(const Frame& F, int b, int ch) {
    const bf16_t* MID = (const bf16_t*)(F.ws + WS_MID); unsigned short* IDX = (unsigned short*)(F.ws + WS_IDX);
    const int lane = F.lane, w = F.wave, r = lane & 31, hi = lane >> 5;
    const int limit = 64 * (ch + 1), tok0 = b * SEQ + 64 * ch;
    LAS unsigned* hist = (LAS unsigned*)(F.lds + w * 16384);
    LAS unsigned short* outl = (LAS unsigned short*)hist;
    if (limit <= 256) {
#pragma unroll
        for (int qq = 0; qq < 8; ++qq) { const int tok = tok0 + 8 * w + qq; u32x2 o; o.x = (4u * lane) | ((4u * lane + 1u) << 16); o.y = (4u * lane + 2u) | ((4u * lane + 3u) << 16);
            *(u32x2*)(IDX + (size_t)tok * 256 + 4 * lane) = o; }
        return;
    }
    bf16x8 a[4];
    { const bf16_t* ap = MID + (size_t)(tok0 + 8 * w + (r >> 2)) * 512 + 128 + (r & 3) * 64 + 8 * hi;
#pragma unroll
      for (int s = 0; s < 4; ++s) a[s] = *(const bf16x8*)(ap + 16 * s); }
    float wv[4][4];
#pragma unroll
    for (int g = 0; g < 4; ++g) { const u32x2 ww = *(const u32x2*)(MID + (size_t)(tok0 + 8 * w + 2 * g + hi) * 512 + 448);
        wv[g][0] = bflo(ww.x) * 0.0625f; wv[g][1] = bfhi(ww.x) * 0.0625f; wv[g][2] = bflo(ww.y) * 0.0625f; wv[g][3] = bfhi(ww.y) * 0.0625f; }
    asm volatile("" :: "v"(a[0]), "v"(a[1]), "v"(a[2]), "v"(a[3]));
    asm volatile("" :: "v"(wv[0][0]), "v"(wv[0][1]), "v"(wv[0][2]), "v"(wv[0][3]), "v"(wv[1][0]), "v"(wv[1][1]), "v"(wv[1][2]), "v"(wv[1][3]),
                       "v"(wv[2][0]), "v"(wv[2][1]), "v"(wv[2][2]), "v"(wv[2][3]), "v"(wv[3][0]), "v"(wv[3][1]), "v"(wv[3][2]), "v"(wv[3][3]));
    constexpr int EB = ((127 - 13) << 5) - 32;
    unsigned Gc[4], Ec[4], ceq[4]; bool lst[4]; float mxa[4]; float eLo[4] = {0.f, 0.f, 0.f, 0.f}, eHi[4] = {0.f, 0.f, 0.f, 0.f}; float vmin[4] = {3e38f, 3e38f, 3e38f, 3e38f}, vmax[4] = {-3e38f, -3e38f, -3e38f, -3e38f}, tmn[4] = {0.f, 0.f, 0.f, 0.f}; int tsel[4] = {-1, -1, -1, -1}, tuns[4] = {1 << 30, 1 << 30, 1 << 30, 1 << 30};
#pragma unroll
    for (int g = 0; g < 4; ++g) { Gc[g] = 0; Ec[g] = 0; ceq[g] = 0; lst[g] = false; mxa[g] = 0.f; }
    const int npair = ch + 1;
    LAS unsigned char* ktl = F.lds + LDS_GEMM + LDS_MISC;
    const bf16_t* gsrc = MID + (size_t)(b * SEQ + (F.tid >> 3)) * 512 + 384 + (F.tid & 7) * 8;
    const unsigned swoff = (unsigned)(F.tid >> 3) * 144u + (unsigned)(F.tid & 7) * 16u, rdoff = (unsigned)r * 144u + (unsigned)hi * 16u;
    int pb2[4], pb4[4];
#pragma unroll
    for (int g = 0; g < 4; ++g) { const int pb_ = (int)(unsigned)(__SIZE_TYPE__)(hist + g * 1024); pb2[g] = __builtin_amdgcn_readfirstlane(pb_ >> 1); pb4[g] = __builtin_amdgcn_readfirstlane((pb_ + 2688) >> 2); }
    int hb[4];
#pragma unroll
    for (int g = 0; g < 4; ++g) { hb[g] = (int)(unsigned)(__SIZE_TYPE__)(hist + (2 * g + hi) * 512 + 256); }
    int qc[4] = {0, 0, 0, 0}, gcnt[4] = {0, 0, 0, 0};
    auto edrain = [&](const int g, const bool full) __attribute__((always_inline)) {
        LAS float* qs = (LAS float*)(hist + g * 1024 + 672); LAS unsigned* qi = hist + g * 1024 + 864;
        const int n = qc[g];
        const bool act = full || lane < n;
        const float es = qs[lane]; const unsigned ei = qi[lane];
        const unsigned th = ei >> 15; const unsigned short kid = (unsigned short)(ei & 0x7fffu);
#pragma unroll
        for (int X = 0; X < 2; ++X) { const bool mine = act & (th == (unsigned)X);
            const unsigned long long me = __ballot(mine);
            const unsigned ce0 = (unsigned)__builtin_amdgcn_readlane((int)ceq[g], 32 * X), G0 = (unsigned)__builtin_amdgcn_readlane((int)Gc[g], 32 * X), E0 = (unsigned)__builtin_amdgcn_readlane((int)Ec[g], 32 * X);
            const bool l0 = __builtin_amdgcn_readlane((int)lst[g], 32 * X) != 0;
            if (mine) { const unsigned rk = ce0 + mbcnt64(me);
                if (l0) { if (rk < 128u) { outl[g * 2048 + 512 + X * 128 + rk] = kid; hist[g * 1024 + X * 128 + rk] = f2key(es); } }
                else if (rk < E0) { const unsigned ps = G0 + rk; if (ps < 256u) IDX[(size_t)(tok0 + 8 * w + 2 * g + X) * 256 + ps] = kid; } }
            if (hi == X) ceq[g] += (unsigned)__popcll(me); }
        if (full) { const int rem = n - 64; if (lane < rem) { const float t1 = qs[64 + lane]; const unsigned t2 = qi[64 + lane]; qs[lane] = t1; qi[lane] = t2; } qc[g] = rem; }
        else qc[g] = 0;
    };
    auto run_pass = [&](auto PT_) __attribute__((always_inline)) {
        constexpr int pass = decltype(PT_)::value;
        const int nr = pass < 0 ? (npair < 4 ? npair : 4) : npair;
        RACC0();
        if (pass == 0) {
#pragma unroll
            for (int i = 0; i < 16; ++i) *(LAS u32x4*)(hist + 4 * lane + 256 * i) = (u32x4){0u, 0u, 0u, 0u};
        }
        if (pass == 2) {
#pragma unroll
            for (int g = 0; g < 4; ++g) { gcnt[g] = 0; qc[g] = 0; }
        }
        LDS_WAIT();
#define KT_PTR(T) (gsrc + (size_t)((T) < npair ? (T) : npair - 1) * 64 * 512)
#define KT_ISSUE(DST, T) asm volatile("global_load_dwordx4 %0, %1, off" : "=v"(DST) : "v"(KT_PTR(T)) : "memory")
#define KT_WAIT(DST, N) asm volatile("s_waitcnt vmcnt(" #N ")" : "+v"(DST) :: "memory")
#define TK_SCORE4(AC, KT) do { float sc[4]; \
        _Pragma("unroll") for (int g = 0; g < 4; ++g) { \
            const float r0 = relu_i(AC[4 * g]), r1 = relu_i(AC[4 * g + 1]), r2 = relu_i(AC[4 * g + 2]), r3 = relu_i(AC[4 * g + 3]); \
            sc[g] = __fmaf_rn(wv[g][3], r3, __fmaf_rn(wv[g][2], r2, __fmaf_rn(wv[g][1], r1, __fmul_rn(wv[g][0], r0)))); } \
        if (pass < 0) { \
            _Pragma("unroll") for (int g = 0; g < 4; ++g) mxa[g] = fmaxf(mxa[g], __builtin_fabsf(sc[g])); \
        } else if (pass == 3) {     \
            const unsigned ix_ = (unsigned)(KT) * 32u + (unsigned)r; \
            _Pragma("unroll") for (int g = 0; g < 4; ++g) { const bool sel_ = (hist[(2 * g + hi) * 512 + 256 + (ix_ >> 5)] >> (ix_ & 31u)) & 1u; \
                vmin[g] = sel_ ? fminf(vmin[g], sc[g]) : vmin[g]; vmax[g] = sel_ ? vmax[g] : fmaxf(vmax[g], sc[g]); } \
        } else if (pass == 4) {     \
            const unsigned ix_ = (unsigned)(KT) * 32u + (unsigned)r; \
            _Pragma("unroll") for (int g = 0; g < 4; ++g) { const bool sel_ = (hist[(2 * g + hi) * 512 + 256 + (ix_ >> 5)] >> (ix_ & 31u)) & 1u; \
                if (sc[g] == tmn[g]) { if (sel_) tsel[g] = max(tsel[g], (int)ix_); else tuns[g] = min(tuns[g], (int)ix_); } } \
        } else if (pass == 0) {     \
            _Pragma("unroll") for (int g = 0; g < 4; ++g) { const int x = tk_xbin(sc[g]); \
                const unsigned inc_ = 1u << ((x & 1) << 4); const int ad_ = hb[g] + ((x >> 1) << 2); \
                asm volatile("ds_add_u32 %0, %1" :: "v"(ad_), "v"(inc_) : "memory"); }        \
        } else {     \
            const unsigned kix_ = (unsigned)((KT) * 32 + r) | ((unsigned)hi << 15); \
            _Pragma("unroll") for (int g = 0; g < 4; ++g) { const bool gt_ = sc[g] >= eHi[g], ge_ = sc[g] >= eLo[g]; \
                const unsigned long long mg_ = __ballot(gt_), me_ = __ballot(ge_) & ~mg_; \
                const int ag_ = ((int)mbcnt64(mg_) + gcnt[g] + pb2[g]) << 1, ae_ = ((int)mbcnt64(me_) + qc[g] + pb4[g]) << 2; \
                  \
                asm volatile("s_mov_b64 exec, %0\n\tds_write_b16 %1, %2 offset:1536\n\ts_mov_b64 exec, -1" :: "s"(mg_), "v"(ag_), "v"(kix_) : "memory"); \
                asm volatile("s_mov_b64 exec, %0\n\tds_write2st64_b32 %1, %2, %3 offset0:0 offset1:3\n\ts_mov_b64 exec, -1" :: "s"(me_), "v"(ae_), "v"(sc[g]), "v"(kix_) : "memory"); \
                gcnt[g] += __popcll(mg_); qc[g] += __popcll(me_); } \
            if ((qc[0] | qc[1] | qc[2] | qc[3]) >= 64) {     \
                _Pragma("unroll") for (int g = 0; g < 4; ++g) if (qc[g] >= 64) edrain(g, true); } } } while (0)
        u32x4 g0, g1, gqA, gqB, gqC, gqD;
        KT_ISSUE(g0, 0); KT_ISSUE(g1, 1); KT_ISSUE(gqA, 2); KT_ISSUE(gqB, 3); KT_ISSUE(gqC, 4); KT_ISSUE(gqD, 5);
        asm volatile("s_waitcnt vmcnt(4)" : "+v"(g0), "+v"(g1) :: "memory");
        *(LAS u32x4*)(ktl + swoff) = g0; *(LAS u32x4*)(ktl + 9216 + swoff) = g1;
        __syncthreads();
        bf16x8 bkX[4], bkY[4];
#pragma unroll
        for (int s = 0; s < 4; ++s) { bkX[s] = *(const LAS bf16x8*)(ktl + rdoff + s * 32); bkY[s] = *(const LAS bf16x8*)(ktl + rdoff + 32 * 144 + s * 32); }
        f32x16 accX, accY;
#pragma unroll
        for (int i = 0; i < 16; ++i) { accX[i] = 0.f; accY[i] = 0.f; }
#pragma unroll
        for (int s = 0; s < 4; ++s) accX = __builtin_amdgcn_mfma_f32_32x32x16_bf16(a[s], bkX[s], accX, 0, 0, 0);
        int bc = 0, bn = 1, bs = 2;
#define TK_STEP(BKC, BKN, ACCC, ACCP, KT, NXP) { \
            _Pragma("unroll") for (int i = 0; i < 16; ++i) ACCC[i] = 0.f; \
            _Pragma("unroll") for (int s = 0; s < 4; ++s) ACCC = __builtin_amdgcn_mfma_f32_32x32x16_bf16(a[s], BKC[s], ACCC, 0, 0, 0); \
            _Pragma("unroll") for (int s = 0; s < 4; ++s) BKN[s] = *(const LAS bf16x8*)((NXP) + s * 32); \
            TK_SCORE4(ACCP, (KT)); }
#define TK_ROUND(GQ) { \
            TK_STEP(bkY, bkX, accY, accX, 2 * it, ktl + bn * 9216 + rdoff) \
            TK_STEP(bkX, bkY, accX, accY, 2 * it + 1, ktl + bn * 9216 + rdoff + 32 * 144) \
            KT_WAIT(GQ, 3); \
            *(LAS u32x4*)(ktl + bs * 9216 + swoff) = GQ; \
            KT_ISSUE(GQ, it + 6); \
            { const int t_ = bc; bc = bn; bn = bs; bs = t_; } \
            __syncthreads(); }
#pragma unroll 1
        for (int it0 = 0; it0 < nr; it0 += 4) {
            { const int it = it0;     if (it < nr) TK_ROUND(gqA) }
            { const int it = it0 + 1; if (it < nr) TK_ROUND(gqB) }
            { const int it = it0 + 2; if (it < nr) TK_ROUND(gqC) }
            { const int it = it0 + 3; if (it < nr) TK_ROUND(gqD) }
        }
        asm volatile("s_waitcnt vmcnt(0)" : "+v"(gqA), "+v"(gqB), "+v"(gqC), "+v"(gqD) :: "memory");
        if (pass == 2) { edrain(0, false); edrain(1, false); edrain(2, false); edrain(3, false); }
#undef TK_STEP
#undef TK_SCORE4
#undef TK_ROUND
#undef KT_PTR
#undef KT_ISSUE
#undef KT_WAIT
        LDS_WAIT();
        if (pass < 0) {
#pragma unroll
            for (int g = 0; g < 4; ++g) { float v = mxa[g];
#pragma unroll
                for (int o = 1; o < 32; o <<= 1) v = fmaxf(v, __shfl_xor(v, o));
                const int eS = (int)((__float_as_uint(v) >> 23) & 0xffu), k_ = 127 - min(max(eS, 63), 191);
#pragma unroll
                for (int j = 0; j < 4; ++j) wv[g][j] = __builtin_ldexpf(wv[g][j], k_); }
        } else if (pass == 0) {
#pragma unroll
            for (int h4 = 0; h4 < 2; ++h4) { const unsigned nd[4] = {256u, 256u, 256u, 256u}; unsigned bn4[4], ab4[4], cb4[4]; find_thr_c<4>(hist + h4 * 4 * 512, nd, lane, bn4, ab4, cb4);
#pragma unroll
                for (int i = 0; i < 4; ++i) { const int qq = h4 * 4 + i; if ((qq & 1) == hi) { Gc[qq >> 1] = ab4[i]; Ec[qq >> 1] = 256u - ab4[i]; lst[qq >> 1] = cb4[i] <= 128u;
                    eLo[qq >> 1] = tk_edge((int)bn4[i], EB); eHi[qq >> 1] = tk_edge((int)bn4[i] + 1, EB); } } }
        } else if (pass == 2) {
            { const int nmax = max(max(gcnt[0], gcnt[1]), max(gcnt[2], gcnt[3])); unsigned c0[4] = {0u, 0u, 0u, 0u}, c1[4] = {0u, 0u, 0u, 0u};
#pragma unroll 1
              for (int base = 0; base < nmax; base += 64) { unsigned e[4];
#pragma unroll
                for (int g = 0; g < 4; ++g) e[g] = (unsigned)outl[g * 2048 + 768 + base + lane];
#pragma unroll
                for (int g = 0; g < 4; ++g) { const bool v = base + lane < gcnt[g]; const bool h1 = (e[g] >> 15) != 0u; const unsigned short kid = (unsigned short)(e[g] & 0x7fffu);
                    const unsigned long long m0 = __ballot(v & !h1), m1 = __ballot(v & h1);
                    const unsigned pos = h1 ? c1[g] + mbcnt64(m1) : c0[g] + mbcnt64(m0);
                    if (v & (pos < 256u)) IDX[(size_t)(tok0 + 8 * w + 2 * g + (h1 ? 1 : 0)) * 256 + pos] = kid;
                    c0[g] += (unsigned)__popcll(m0); c1[g] += (unsigned)__popcll(m1); } } }
#pragma unroll 1
            for (int qq = 0; qq < 8; ++qq) { const int g = qq >> 1, sl = (qq & 1) * 32;
                const unsigned nl = min(__shfl(ceq[g], sl), 128u), E = __shfl(Ec[g], sl), G = __shfl(Gc[g], sl); const bool lm_ = __shfl((int)lst[g], sl) != 0;
                if (lm_ && nl > 0u) {
                    const LAS unsigned* lk = hist + g * 1024 + (qq & 1) * 128; const LAS unsigned short* li = outl + g * 2048 + 512 + (qq & 1) * 128;
                    const unsigned k0 = (unsigned)lane < nl ? lk[lane] : 0u, k1 = (unsigned)lane + 64u < nl ? lk[lane + 64] : 0u;
                    const unsigned i0 = (unsigned)lane < nl ? li[lane] : 0u, i1 = (unsigned)lane + 64u < nl ? li[lane + 64] : 0u;
                    unsigned r0 = 0u, r1 = 0u;
                    const unsigned nlo = min(nl, 64u);
#pragma unroll 1
                    for (unsigned j = 0; j < nlo; ++j) { const unsigned kj = (unsigned)__builtin_amdgcn_readlane((int)k0, (int)j), ij = (unsigned)__builtin_amdgcn_readlane((int)i0, (int)j);
                        r0 += (kj > k0) | ((kj == k0) & (ij < i0)); if (nl > 64u) r1 += (kj > k1) | ((kj == k1) & (ij < i1)); }
#pragma unroll 1
                    for (unsigned j = 64; j < nl; ++j) { const unsigned kj = (unsigned)__builtin_amdgcn_readlane((int)k1, (int)(j - 64u)), ij = (unsigned)__builtin_amdgcn_readlane((int)i1, (int)(j - 64u));
                        r0 += (kj > k0) | ((kj == k0) & (ij < i0)); r1 += (kj > k1) | ((kj == k1) & (ij < i1)); }
                    unsigned short* oq = IDX + (size_t)(tok0 + 8 * w + qq) * 256;
                    if ((unsigned)lane < nl && r0 < E && G + r0 < 256u) oq[G + r0] = (unsigned short)i0;
                    if ((unsigned)lane + 64u < nl && r1 < E && G + r1 < 256u) oq[G + r1] = (unsigned short)i1;
                } }
        }
        LDS_WAIT();
        RACC(pass < 0 ? 41 : pass == 0 ? 42 : 43);
    };
#ifdef TK_VALIDATE_OLD
    run_pass(std::integral_constant<int, -1>{});
#else
    run_pass(std::integral_constant<int, -1>{}); run_pass(std::integral_constant<int, 0>{}); run_pass(std::integral_constant<int, 2>{});
#endif
#ifdef TK_VALIDATE
    {
        asm volatile("s_waitcnt vmcnt(0)" ::: "memory");
#pragma unroll 1
        for (int qq = 0; qq < 8; ++qq) for (int i = 0; i < 4; ++i) outl[qq * 1024 + lane * 4 + i] = __hip_atomic_load(IDX + (size_t)(tok0 + 8 * w + qq) * 256 + lane * 4 + i, __ATOMIC_RELAXED, __HIP_MEMORY_SCOPE_AGENT);
        LDS_WAIT();
#pragma unroll 1
        for (int qq = 0; qq < 8; ++qq) { *(LAS u32x4*)(hist + qq * 512 + 256 + 4 * lane) = (u32x4){0u, 0u, 0u, 0u}; }
        LDS_WAIT();
#pragma unroll 1
        for (int qq = 0; qq < 8; ++qq) for (int i = 0; i < 4; ++i) { const unsigned ix = outl[qq * 1024 + lane * 4 + i]; (void)__hip_atomic_fetch_or(hist + qq * 512 + 256 + (ix >> 5), 1u << (ix & 31u), __ATOMIC_RELAXED, __HIP_MEMORY_SCOPE_WORKGROUP); }
        LDS_WAIT();
        run_pass(std::integral_constant<int, 3>{});
#pragma unroll
        for (int g = 0; g < 4; ++g) { float mn = vmin[g], mx = vmax[g];
#pragma unroll
            for (int o = 1; o < 32; o <<= 1) { mn = fminf(mn, __shfl_xor(mn, o)); mx = fmaxf(mx, __shfl_xor(mx, o)); }
            const float scale_ = 1.0f;
            if (r == 0 && (mx - mn) > scale_ * TK_VALIDATE_TOL) atomicAdd((int*)(F.ws + WS_CTL) + 64, 1);
            tmn[g] = mn; }
#ifdef TK_VALIDATE_TIES
        run_pass(std::integral_constant<int, 4>{});
#pragma unroll
        for (int g = 0; g < 4; ++g) { int a_ = tsel[g], b_ = tuns[g];
#pragma unroll
            for (int o = 1; o < 32; o <<= 1) { a_ = max(a_, __shfl_xor(a_, o)); b_ = min(b_, __shfl_xor(b_, o)); }
            if (r == 0 && a_ > b_) atomicAdd((int*)(F.ws + WS_CTL) + 64, 1); }
#endif
    }
#endif
    LDS_WAIT();
}
__device__ __forceinline__ void phase_topk(const Frame& F) {
#if !defined(TK_VALIDATE_OLD) && !defined(TK_XCHECK)
    if (F.G % 8 == 0) {
        unsigned* ctr = (unsigned*)(F.ws + WS_CTL + 40960);
        LAS int* tk = (LAS int*)(F.lds + LDS_GEMM + 1024);
        unsigned v = 0u; if (F.tid == 0) v = __builtin_amdgcn_atomic_inc32(ctr, 0xffffffffu, __ATOMIC_RELAXED, "agent");
        for (;;) {
            if (F.tid == 0) *tk = (int)v;
            __syncthreads();
            const int n = *tk;
            __syncthreads();
            if (n >= 1024) break;
            if (F.tid == 0) v = __builtin_amdgcn_atomic_inc32(ctr, 0xffffffffu, __ATOMIC_RELAXED, "agent");
            topk_unit(F, n & 7, 127 - (n >> 3));
        }
        return;
    }
#endif
    for (int j = F.bid; j < 256; j += F.G) { const int b = j & 7, pp = j >> 3;
#pragma unroll 1
        for (int u = 0; u < 4; ++u) { const int ch = u == 0 ? 127 - pp : u == 1 ? 64 + pp : u == 2 ? 63 - pp : pp;
#ifdef TK_VALIDATE_OLD
            topk_unit_ref(F, b, ch, (unsigned short*)(F.ws + WS_IDX)); __syncthreads();
#endif
            topk_unit(F, b, ch);
#ifdef TK_XCHECK
            {
                unsigned short* IDX = (unsigned short*)(F.ws + WS_IDX); unsigned short* IDX2 = (unsigned short*)(F.ws + 848 * MiB);
                __syncthreads();
                topk_unit_ref(F, b, ch, IDX2);
                __syncthreads();
                if (64 * (ch + 1) > 256) { LAS unsigned* bm = (LAS unsigned*)(F.lds + F.wave * 16384);
                    for (int qq = 0; qq < 8; ++qq) { const int tok = b * SEQ + 64 * ch + 8 * F.wave + qq;
                        asm volatile("s_waitcnt vmcnt(0)" ::: "memory");
                        *(LAS u32x4*)(bm + 4 * F.lane) = (u32x4){0u, 0u, 0u, 0u}; LDS_WAIT();
                        for (int i = 0; i < 4; ++i) { const unsigned ix = __hip_atomic_load(IDX + (size_t)tok * 256 + F.lane * 4 + i, __ATOMIC_RELAXED, __HIP_MEMORY_SCOPE_AGENT); (void)__hip_atomic_fetch_or(bm + (ix >> 5), 1u << (ix & 31), __ATOMIC_RELAXED, __HIP_MEMORY_SCOPE_WORKGROUP); }
                        LDS_WAIT(); int miss = 0;
                        for (int i = 0; i < 4; ++i) { const unsigned ix = __hip_atomic_load(IDX2 + (size_t)tok * 256 + F.lane * 4 + i, __ATOMIC_RELAXED, __HIP_MEMORY_SCOPE_AGENT); miss += ((bm[ix >> 5] >> (ix & 31)) & 1u) ? 0 : 1; }
                        for (int o = 1; o < 64; o <<= 1) miss += __shfl_xor(miss, o);
                        if (F.lane == 0 && miss > XCHECK_TOL) atomicAdd((int*)(F.ws + WS_CTL) + 64, 1);
                        LDS_WAIT(); } }
                __syncthreads();
            }
#endif
        } }
}

__device__ __forceinline__ unsigned off_b(unsigned row, unsigned ch) { return 256u * row + 16u * (ch ^ (((row & 3u) << 2) | ((row >> 2) & 3u))); }
__device__ __forceinline__ s16x4 tr_read(unsigned lds_addr) { s16x4 r; asm volatile("ds_read_b64_tr_b16 %0, %1\n\ts_waitcnt lgkmcnt(0)" : "=&v"(r) : "v"(lds_addr) : "memory"); return r; }

#define TR8(OFS, T0, T1, T2, T3, T4, T5, T6, T7, H) asm volatile( \
        "ds_read_b64_tr_b16 %0, %8 offset:" #OFS "\n\tds_read_b64_tr_b16 %1, %9 offset:" #OFS "\n\tds_read_b64_tr_b16 %2, %10 offset:" #OFS "\n\tds_read_b64_tr_b16 %3, %11 offset:" #OFS "\n\t" \
        "ds_read_b64_tr_b16 %4, %12 offset:" #OFS "\n\tds_read_b64_tr_b16 %5, %13 offset:" #OFS "\n\tds_read_b64_tr_b16 %6, %14 offset:" #OFS "\n\tds_read_b64_tr_b16 %7, %15 offset:" #OFS "\n\ts_waitcnt lgkmcnt(0)" \
        : "=&v"(T0), "=&v"(T1), "=&v"(T2), "=&v"(T3), "=&v"(T4), "=&v"(T5), "=&v"(T6), "=&v"(T7) \
        : "v"(tra[4 * (H)][0]), "v"(tra[4 * (H)][1]), "v"(tra[4 * (H) + 1][0]), "v"(tra[4 * (H) + 1][1]), "v"(tra[4 * (H) + 2][0]), "v"(tra[4 * (H) + 2][1]), "v"(tra[4 * (H) + 3][0]), "v"(tra[4 * (H) + 3][1]) \
        : "memory")
__device__ __forceinline__ void attn_prefetch(const Frame& F, int b, int t, const LAS unsigned short* idxq, bf16x8 (&bq)[4], u32x4 (&pre)[16]) {
    const bf16_t* QLAT = (const bf16_t*)(F.ws + WS_QLAT); const bf16_t* C = (const bf16_t*)(F.ws + WS_C);
    const int lane = F.lane, q4 = lane >> 4, hd = lane & 15; const int tok = b * SEQ + t;
#pragma unroll
    for (int s = 0; s < 4; ++s) { bq[s] = (bf16x8){0, 0, 0, 0, 0, 0, 0, 0}; if (hd < 8) bq[s] = *(const bf16x8*)(QLAT + (size_t)tok * 1024 + hd * 128 + 32 * s + 8 * q4); }
    const bf16_t* cb = C + (size_t)b * SEQ * 128 + hd * 8;
#pragma unroll
    for (int i = 0; i < 16; ++i) { const unsigned key = idxq[q4 + 4 * i]; pre[i] = *(const u32x4*)(cb + (size_t)key * 128); }
}
__device__ __forceinline__ void attn_query(const Frame& F, int b, int t, bool has_next, int nb, int nt, LAS unsigned char* tile, LAS unsigned short* idxl, LAS unsigned short* idxn, const LAS float* biasl, LAS unsigned char* bktl,
                                           bf16x8 (&bq)[4], u32x4 (&pre)[16]) {
    bf16_t* QLAT = (bf16_t*)(F.ws + WS_QLAT); const bf16_t* C = (const bf16_t*)(F.ws + WS_C); const unsigned short* IDX = (const unsigned short*)(F.ws + WS_IDX);
    const int lane = F.lane, q4 = lane >> 4, hd = lane & 15;
    const int tok = b * SEQ + t, limit = (t / 64 + 1) * 64, nsel = limit < 256 ? limit : 256, niter = nsel / 64;
    u32x4 nidx = (u32x4){0u, 0u, 0u, 0u};
    if (has_next && lane < 32) nidx = *(const u32x4*)(IDX + (size_t)(nb * SEQ + nt) * 256 + lane * 8);
    {
        const u32x2 kk = *(const LAS u32x2*)(idxl + 4 * lane); unsigned pk = 0u;
#pragma unroll
        for (int i = 0; i < 4; ++i) { const int key = (int)((i < 2 ? kk.x : kk.y) >> (16 * (i & 1))) & 0xffff; const int rel = key - t, n = rel < 0 ? -rel : rel;
            int bucket = n < 8 ? n : min(8 + (25 - __clz(n * n)), 15); if (rel > 0) bucket += 16; pk |= (unsigned)bucket << (8 * i); }
        *(LAS unsigned*)(bktl + 4 * lane) = pk;
    }
    f32x4 accO[8];
#pragma unroll
    for (int c = 0; c < 8; ++c) accO[c] = (f32x4){0.f, 0.f, 0.f, 0.f};
    float m_run = -1e30f, l_run = 0.f;
    const bf16_t* cb = C + (size_t)b * SEQ * 128 + hd * 8;
    const unsigned tbase = (unsigned)(size_t)tile;
    unsigned tra[8][2];
    { const unsigned qq = (lane & 15) >> 2, pp = lane & 3;
#pragma unroll
      for (int c = 0; c < 8; ++c) { tra[c][0] = tbase + off_b(8u * q4 + qq, 2 * c + (pp >> 1)) + 8u * (pp & 1); tra[c][1] = tbase + off_b(8u * q4 + 4u + qq, 2 * c + (pp >> 1)) + 8u * (pp & 1); } }
#pragma unroll 1
    for (int it = 0; it < niter; ++it) {
#pragma unroll
        for (int i = 0; i < 16; ++i) *(LAS u32x4*)(tile + (i >> 3) * 8192 + off_b(q4 + 4 * (i & 7), hd)) = pre[i];
        bf16x8 bqc[4];
#pragma unroll
        for (int s = 0; s < 4; ++s) bqc[s] = bq[s];
        if (it + 1 < niter) {
#pragma unroll
            for (int i = 0; i < 16; ++i) { const unsigned key = idxl[64 * (it + 1) + q4 + 4 * i]; pre[i] = *(const u32x4*)(cb + (size_t)key * 128); }
        } else if (has_next) {
            if (lane < 32) *(LAS u32x4*)(idxn + lane * 8) = nidx;
            LDS_WAIT();
            attn_prefetch(F, nb, nt, idxn, bq, pre);
        }
        LDS_WAIT();
        f32x4 sacc[2][2];
#pragma unroll
        for (int u = 0; u < 2; ++u)
#pragma unroll
            for (int rb = 0; rb < 2; ++rb) { sacc[u][rb] = (f32x4){0.f, 0.f, 0.f, 0.f}; const unsigned row = 8u * (hd >> 2) + 4u * rb + (hd & 3);
#pragma unroll
                for (int s = 0; s < 4; ++s) { const bf16x8 A = *(const LAS bf16x8*)(tile + u * 8192 + off_b(row, 4 * s + q4)); sacc[u][rb] = __builtin_amdgcn_mfma_f32_16x16x32_bf16(A, bqc[s], sacc[u][rb], 0, 0, 0); } }
        float lg[16]; float mt = -1e30f;
#pragma unroll
        for (int u = 0; u < 2; ++u) { const u32x2 bk8 = *(const LAS u32x2*)(bktl + 64 * it + 32 * u + 8 * q4);
#pragma unroll
            for (int j = 0; j < 8; ++j) { const unsigned bucket = ((j < 4 ? bk8.x : bk8.y) >> (8 * (j & 3))) & 0xffu;
                lg[8 * u + j] = sacc[u][j >> 2][j & 3] + biasl[bucket * 8 + (hd & 7)]; mt = fmaxf(mt, lg[8 * u + j]); } }
        mt = fmaxf(mt, __shfl_xor(mt, 16)); mt = fmaxf(mt, __shfl_xor(mt, 32));
        const float m_new = fmaxf(m_run, mt), alpha = __builtin_amdgcn_exp2f(m_run - m_new); m_run = m_new;
        float pj[16], ps = 0.f;
#pragma unroll
        for (int j = 0; j < 16; ++j) { pj[j] = __builtin_amdgcn_exp2f(lg[j] - m_new); ps += pj[j]; }
        l_run = l_run * alpha + ps;
#pragma unroll
        for (int c = 0; c < 8; ++c) accO[c] = accO[c] * alpha;
        u32x4 pw0, pw1;
        pw0.x = cvt_pk_bf16(pj[0], pj[1]); pw0.y = cvt_pk_bf16(pj[2], pj[3]); pw0.z = cvt_pk_bf16(pj[4], pj[5]); pw0.w = cvt_pk_bf16(pj[6], pj[7]);
        pw1.x = cvt_pk_bf16(pj[8], pj[9]); pw1.y = cvt_pk_bf16(pj[10], pj[11]); pw1.z = cvt_pk_bf16(pj[12], pj[13]); pw1.w = cvt_pk_bf16(pj[14], pj[15]);
        const bf16x8 pf0 = __builtin_bit_cast(bf16x8, pw0), pf1 = __builtin_bit_cast(bf16x8, pw1);
#define PV4(PF, H, T0, T1, T2, T3, T4, T5, T6, T7) do { \
        accO[4 * (H)]     = __builtin_amdgcn_mfma_f32_16x16x32_bf16(__builtin_shufflevector(T0, T1, 0, 1, 2, 3, 4, 5, 6, 7), PF, accO[4 * (H)], 0, 0, 0); \
        accO[4 * (H) + 1] = __builtin_amdgcn_mfma_f32_16x16x32_bf16(__builtin_shufflevector(T2, T3, 0, 1, 2, 3, 4, 5, 6, 7), PF, accO[4 * (H) + 1], 0, 0, 0); \
        accO[4 * (H) + 2] = __builtin_amdgcn_mfma_f32_16x16x32_bf16(__builtin_shufflevector(T4, T5, 0, 1, 2, 3, 4, 5, 6, 7), PF, accO[4 * (H) + 2], 0, 0, 0); \
        accO[4 * (H) + 3] = __builtin_amdgcn_mfma_f32_16x16x32_bf16(__builtin_shufflevector(T6, T7, 0, 1, 2, 3, 4, 5, 6, 7), PF, accO[4 * (H) + 3], 0, 0, 0); } while (0)
        { s16x4 t0, t1, t2, t3, t4, t5, t6, t7;
          __builtin_amdgcn_s_setprio(1);
          TR8(0, t0, t1, t2, t3, t4, t5, t6, t7, 0); PV4(pf0, 0, t0, t1, t2, t3, t4, t5, t6, t7);
          TR8(0, t0, t1, t2, t3, t4, t5, t6, t7, 1); PV4(pf0, 1, t0, t1, t2, t3, t4, t5, t6, t7);
          TR8(8192, t0, t1, t2, t3, t4, t5, t6, t7, 0); PV4(pf1, 0, t0, t1, t2, t3, t4, t5, t6, t7);
          TR8(8192, t0, t1, t2, t3, t4, t5, t6, t7, 1); PV4(pf1, 1, t0, t1, t2, t3, t4, t5, t6, t7);
          __builtin_amdgcn_s_setprio(0); }
#undef PV4
    }
    float lt = l_run; lt += __shfl_xor(lt, 16); lt += __shfl_xor(lt, 32);
    const float inv = 1.0f / lt;
    if (hd < 8) {
#pragma unroll
        for (int c = 0; c < 8; ++c) { u32x2 o; o.x = cvt_pk_bf16(accO[c][0] * inv, accO[c][1] * inv); o.y = cvt_pk_bf16(accO[c][2] * inv, accO[c][3] * inv);
            *(u32x2*)(QLAT + (size_t)tok * 1024 + hd * 128 + 16 * c + 4 * q4) = o; }
    }
    LDS_WAIT();
}
__device__ __forceinline__ void phase_attn(const Frame& F, const Params& p) {
    LAS unsigned char* tile = F.lds + F.wave * 16384;
    LAS unsigned short* idx0 = (LAS unsigned short*)(F.lds + LDS_GEMM + LDS_MISC + F.wave * 1024);
    LAS float* biasl = (LAS float*)(F.lds + LDS_GEMM + LDS_MISC + 8 * 1024);
    LAS unsigned char* bktl = F.lds + LDS_GEMM + LDS_MISC + 8 * 1024 + 1024 + F.wave * 256;
    if (F.tid < 256) biasl[F.tid] = INP(6)[F.tid] * 1.44269504f;
    __syncthreads();
    const unsigned short* IDX = (const unsigned short*)(F.ws + WS_IDX);
    const bool fast = F.G % 8 == 0; const int per = F.G / 8;
    int m = fast ? (F.bid >> 3) * 8 + F.wave : F.gw; const int mstep = fast ? per * 8 : F.NGW, mend = fast ? SEQ : MTOK;
    if (m >= mend) return;
    int b = fast ? (F.bid & 7) : m / SEQ, t = fast ? m : m % SEQ, par = 0;
    bf16x8 bq[4]; u32x4 pre[16];
    if (F.lane < 32) *(LAS u32x4*)(idx0 + F.lane * 8) = *(const u32x4*)(IDX + (size_t)(b * SEQ + t) * 256 + F.lane * 8);
    LDS_WAIT();
    attn_prefetch(F, b, t, idx0, bq, pre);
#pragma unroll 1
    for (;;) { const int mn = m + mstep; const bool has_next = mn < mend; const int nb = fast ? b : (has_next ? mn / SEQ : b), nt = fast ? mn : (has_next ? mn % SEQ : t);
        attn_query(F, b, t, has_next, nb, nt, tile, idx0 + par * 256, idx0 + (par ^ 1) * 256, biasl, bktl, bq, pre);
        if (!has_next) break;
        m = mn; b = nb; t = nt; par ^= 1; }
}

__device__ __forceinline__ void phase_scan(const Frame& F) {
    const int gt = F.bid * NT + F.tid; if (gt >= NB * 32 * 64) return;
    const int n = gt & 63, g = (gt >> 6) & 31, b = gt >> 11;
    const float* a64 = (const float*)(F.ws + WS_CTL + 1024); const float ar = a64[(g * 64 + n) * 2], ai = a64[(g * 64 + n) * 2 + 1];
    const float* SST = (const float*)(F.ws + WS_SST) + ((size_t)g * 1024 + b * 128) * 128 + n;
    bf16_t* UG = (bf16_t*)(F.ws + WS_UG) + ((size_t)g * 1024 + b * 128) * UGP + 1024 + n;
    float xr = 0.f, xi = 0.f;
    for (int c0 = 0; c0 < 128; c0 += 8) {
        float sr[8], si[8];
#pragma unroll
        for (int k = 0; k < 8; ++k) { sr[k] = SST[(size_t)(c0 + k) * 128]; si[k] = SST[(size_t)(c0 + k) * 128 + 64]; }
#pragma unroll
        for (int k = 0; k < 8; ++k) { bf16_t* u = UG + (size_t)(c0 + k) * UGP; u[0] = f2bf(xr); u[64] = f2bf(xi);
            const float nr = ar * xr - ai * xi + sr[k], ni = ar * xi + ai * xr + si[k]; xr = nr; xi = ni; }
    }
}

__device__ __forceinline__ void route_decide(const Params& p, const float* lg, int& x0o, int& x1o, float& w0o, float& w1o) {
    const f32x4 g4 = *(const f32x4*)lg + *(const f32x4*)INP(22);
    int grp = 0; float gm = g4[0];
#pragma unroll
    for (int k = 1; k < 4; ++k) if (g4[k] > gm) { gm = g4[k]; grp = k; }
    float gs = 0.f;
#pragma unroll
    for (int k = 0; k < 4; ++k) gs += expf(g4[k] - gm);
    const float gval = 1.0f / gs;
    const float* el = lg + 4 + grp * 8; const float* eb = INP(24) + grp * 8;
    const f32x4 e0 = *(const f32x4*)el + *(const f32x4*)eb, e1 = *(const f32x4*)(el + 4) + *(const f32x4*)(eb + 4);
    float ev[8] = {e0[0], e0[1], e0[2], e0[3], e1[0], e1[1], e1[2], e1[3]};
    float em = ev[0];
#pragma unroll
    for (int k = 1; k < 8; ++k) em = fmaxf(em, ev[k]);
    float pe[8];
#pragma unroll
    for (int k = 0; k < 8; ++k) pe[k] = expf(ev[k] - em);
    int i1 = 0; float p1 = pe[0];
#pragma unroll
    for (int k = 1; k < 8; ++k) if (pe[k] > p1) { p1 = pe[k]; i1 = k; }
    int i2 = -1; float p2 = -1.f;
#pragma unroll
    for (int k = 0; k < 8; ++k) if (k != i1 && pe[k] > p2) { p2 = pe[k]; i2 = k; }
    const float wn = gval / (p1 + p2);
    x0o = grp * 8 + i1; x1o = grp * 8 + i2; w0o = p1 * wn; w1o = p2 * wn;
}
__device__ __forceinline__ void phase_route(const Frame& F, const Params& p) {
    const float* X1 = p.out; bf16_t* H2X = (bf16_t*)(F.ws + WS_H2X); int* cnt = (int*)(F.ws + WS_CTL); int* tokinfo = (int*)(F.ws + WS_TOKINFO); float* LOG = (float*)(F.ws + WS_LOGITS);
    const int lane = F.lane; const float* gain = INP(20);
    for (int rt = F.bid; rt < MTOK / 256; rt += F.G) {
        int ln = F.lane; asm volatile("" : "+v"(ln));
        for (int rr = 0; rr < 32; rr += 4) {
            f32x4 v[4][4]; float ss[4];
#pragma unroll
            for (int u = 0; u < 4; ++u) { const float* xr = X1 + (size_t)(rt * 256 + F.wave * 32 + rr + u) * 1024;
#pragma unroll
                for (int j = 0; j < 4; ++j) v[u][j] = __builtin_nontemporal_load((const f32x4*)(xr + 256 * j + 4 * ln)); }
#pragma unroll
            for (int u = 0; u < 4; ++u) { float s = 0.f;
#pragma unroll
                for (int j = 0; j < 4; ++j) s += (v[u][j].x * v[u][j].x + v[u][j].y * v[u][j].y) + (v[u][j].z * v[u][j].z + v[u][j].w * v[u][j].w);
                ss[u] = s; }
#pragma unroll
            for (int o = 1; o < 64; o <<= 1) {
#pragma unroll
                for (int u = 0; u < 4; ++u) ss[u] += __shfl_xor(ss[u], o); }
#pragma unroll
            for (int u = 0; u < 4; ++u) { const int row = rt * 256 + F.wave * 32 + rr + u; const float rstd = 1.0f / sqrtf(ss[u] * (1.0f / 1024.0f) + EPS);
#pragma unroll
                for (int j = 0; j < 4; ++j) { const f32x4 h = v[u][j] * rstd * *(const f32x4*)(gain + 256 * j + 4 * ln);
                    u32x2 o; o.x = cvt_pk_bf16(h.x, h.y); o.y = cvt_pk_bf16(h.z, h.w);
                    u32x2 l; l.x = cvt_pk_bf16(h.x - bflo(o.x), h.y - bfhi(o.x)); l.y = cvt_pk_bf16(h.z - bflo(o.y), h.w - bfhi(o.y));
                    *(u32x2*)(H2X + (size_t)row * 2048 + 256 * j + 4 * ln) = o; *(u32x2*)(H2X + (size_t)row * 2048 + 1024 + 256 * j + 4 * ln) = l; } }
        }
        RSTAMP(32);
        asm volatile("s_waitcnt vmcnt(0)" ::: "memory"); __builtin_amdgcn_fence(__ATOMIC_ACQUIRE, "agent"); asm volatile("s_waitcnt vmcnt(0)" ::: "memory"); __syncthreads();
        { pg8::Gemm g{H2X, (const bf16_t*)(F.ws + WS_WR), 2048, 2048, 2048};
          pg8::Sched S; S.mode = 3; S.nM = 1; S.nN = 1; S.nwg = 1; S.G = 1; S.c = rt; S.tstepA = (size_t)256 * 2048 * 2; S.tstepB = 0; S.zstepA = 0; S.zstepB = 0; S.tile_e = nullptr;
          RSTAMP(33);
          EpiRouter E{LOG}; pg8::gemm_phase(F.lds, g, S, E); }
        RSTAMP(34);
        asm volatile("s_waitcnt vmcnt(0)" ::: "memory"); __builtin_amdgcn_fence(__ATOMIC_ACQUIRE, "agent"); asm volatile("s_waitcnt vmcnt(0)" ::: "memory"); __syncthreads();
        {
            LAS int* cl = (LAS int*)(F.lds + LDS_GEMM);
            int td = threadIdx.x; asm volatile("" : "+v"(td));
            if (td < 64) cl[td] = 0;
            __syncthreads();
            int x0 = 0, x1 = 0, l0 = 0, l1 = 0; float w0 = 0.f, w1 = 0.f;
            if (td < 256) { route_decide(p, LOG + (size_t)(rt * 256 + td) * 64, x0, x1, w0, w1);
                l0 = __hip_atomic_fetch_add(cl + x0, 1, __ATOMIC_RELAXED, __HIP_MEMORY_SCOPE_WORKGROUP); l1 = __hip_atomic_fetch_add(cl + x1, 1, __ATOMIC_RELAXED, __HIP_MEMORY_SCOPE_WORKGROUP); }
            __syncthreads();
            if (td < 32) { const int c = cl[td]; cl[32 + td] = c ? atomicAdd(cnt + td, c) : 0; }
            __syncthreads();
            if (td < 256) { int* ti = tokinfo + (size_t)(rt * 256 + td) * 8; ti[0] = x0; ti[1] = cl[32 + x0] + l0; ti[2] = x1; ti[3] = cl[32 + x1] + l1; ((float*)ti)[4] = w0; ((float*)ti)[5] = w1; }
            __syncthreads();
        }
    }
}
__device__ __forceinline__ int expert_base(const Frame& F, int* tot) {
    const int* cnt = (const int*)(F.ws + WS_CTL);
    const int c = F.lane < 32 ? cnt[F.lane] : 0; const int pd = (c + 255) & ~255;
    int inc = pd;
#pragma unroll
    for (int off = 1; off < 64; off <<= 1) { const int v = __shfl_up(inc, off); if (F.lane >= off) inc += v; }
    *tot = __shfl(inc, 63);
    return inc - pd;
}
__device__ __forceinline__ void phase_scatter(const Frame& F) {
    const bf16_t* H2 = (const bf16_t*)(F.ws + WS_H2X); bf16_t* XS = (bf16_t*)(F.ws + WS_XS); const int* tokinfo = (const int*)(F.ws + WS_TOKINFO); int* tokslot = (int*)(F.ws + WS_TOKSLOT);
    int tot; const int base = expert_base(F, &tot);
    int ne0 = 0, np0 = 0, ne1 = 0, np1 = 0;
    if (F.gw < MTOK) { const int* ti = tokinfo + (size_t)F.gw * 8; ne0 = ti[0]; np0 = ti[1]; ne1 = ti[2]; np1 = ti[3]; }
    for (int m = F.gw; m < MTOK; m += F.NGW) {
        const int e0 = ne0, pos0 = np0, e1 = ne1, pos1 = np1;
        { const int mn = m + F.NGW < MTOK ? m + F.NGW : m; const int* ti = tokinfo + (size_t)mn * 8; ne0 = ti[0]; np0 = ti[1]; ne1 = ti[2]; np1 = ti[3]; }
        const int s0 = __shfl(base, e0) + pos0, s1 = __shfl(base, e1) + pos1;
        const u32x4 a = *(const u32x4*)(H2 + (size_t)m * 2048 + 8 * F.lane), bb = *(const u32x4*)(H2 + (size_t)m * 2048 + 512 + 8 * F.lane);
        *(u32x4*)(XS + (size_t)s0 * 1024 + 8 * F.lane) = a; *(u32x4*)(XS + (size_t)s0 * 1024 + 512 + 8 * F.lane) = bb;
        *(u32x4*)(XS + (size_t)s1 * 1024 + 8 * F.lane) = a; *(u32x4*)(XS + (size_t)s1 * 1024 + 512 + 8 * F.lane) = bb;
        if (F.lane == 0) { tokslot[(size_t)m * 2] = s0; tokslot[(size_t)m * 2 + 1] = s1; }
    }
}
__device__ __forceinline__ int build_tile_table(const Frame& F, LAS int* tile_e) {
    const int* cnt = (const int*)(F.ws + WS_CTL);
    int total = 0; int tid_ = threadIdx.x; asm volatile("" : "+v"(tid_));
    for (int rt = tid_; rt < MOE_ROWS / 256; rt += NT) { int acc = 0, e = 31;
        for (int k = 0; k < 32; ++k) { const int nt_ = (cnt[k] + 255) >> 8; if (rt >= acc && rt < acc + nt_) e = k; acc += nt_; }
        tile_e[rt] = e; }
    for (int k = 0; k < 32; ++k) total += (cnt[k] + 255) >> 8;
    __syncthreads();
    return total;
}
__device__ __forceinline__ void phase_final(const Frame& F, const Params& p) {
    const bf16_t* YS = (const bf16_t*)(F.ws + WS_YS); const int* tokinfo = (const int*)(F.ws + WS_TOKINFO); const int* tokslot = (const int*)(F.ws + WS_TOKSLOT);
    const float* gain = INP(28); const int lane = F.lane;
#if defined(TK_XCHECK) || defined(TK_VALIDATE)
    const float poison = ((const int*)(F.ws + WS_CTL))[64] > 0 ? __builtin_nanf("") : 1.0f;
#else
    const float poison = 1.0f;
#endif
    int ns0 = 0, ns1 = 0; float nw0 = 0.f, nw1 = 0.f;
    if (F.gw < MTOK) { ns0 = tokslot[(size_t)F.gw * 2]; ns1 = tokslot[(size_t)F.gw * 2 + 1]; nw0 = ((const float*)(tokinfo + (size_t)F.gw * 8))[4]; nw1 = ((const float*)(tokinfo + (size_t)F.gw * 8))[5]; }
    for (int m = F.gw; m < MTOK; m += F.NGW) {
        const int s0 = ns0, s1 = ns1; const float w0 = nw0, w1 = nw1;
        { const int mn = m + F.NGW < MTOK ? m + F.NGW : m; ns0 = tokslot[(size_t)mn * 2]; ns1 = tokslot[(size_t)mn * 2 + 1]; nw0 = ((const float*)(tokinfo + (size_t)mn * 8))[4]; nw1 = ((const float*)(tokinfo + (size_t)mn * 8))[5]; }
        float* xr = p.out + (size_t)m * 1024; f32x4 v[4]; float s = 0.f;
#pragma unroll
        for (int j = 0; j < 4; ++j) { v[j] = __builtin_nontemporal_load((const f32x4*)(xr + 256 * j + 4 * lane));
            const u32x2 a = __builtin_nontemporal_load((const u32x2*)(YS + (size_t)s0 * 1024 + 256 * j + 4 * lane)), bb = __builtin_nontemporal_load((const u32x2*)(YS + (size_t)s1 * 1024 + 256 * j + 4 * lane));
            v[j].x += w0 * bflo(a.x) + w1 * bflo(bb.x); v[j].y += w0 * bfhi(a.x) + w1 * bfhi(bb.x); v[j].z += w0 * bflo(a.y) + w1 * bflo(bb.y); v[j].w += w0 * bfhi(a.y) + w1 * bfhi(bb.y);
            s += (v[j].x * v[j].x + v[j].y * v[j].y) + (v[j].z * v[j].z + v[j].w * v[j].w); }
        const float rstd = 1.0f / sqrtf(wave_sum(s) * (1.0f / 1024.0f) + EPS);
#pragma unroll
        for (int j = 0; j < 4; ++j) { const f32x4 gg = *(const f32x4*)(gain + 256 * j + 4 * lane); __builtin_nontemporal_store(v[j] * (rstd * poison) * gg, (f32x4*)(xr + 256 * j + 4 * lane)); }
    }
}

#define XB_TMO      128
#define XB_XCNT(j)  (256  + 64 * (j))
#define XB_XSUB(j)  (1280 + 64 * (j))
#define XB_XGEN(j)  (2304 + 64 * (j))
#define XB_TOP      3328
#define XB_TOPGEN   3392
#define XCD_BAR_WORDS 3456
#define XB_SPIN_CAP (1u << 18)
__device__ __forceinline__ unsigned xb_ld(unsigned* p)              { return __hip_atomic_load(p, __ATOMIC_RELAXED, __HIP_MEMORY_SCOPE_AGENT); }
__device__ __forceinline__ unsigned xb_add(unsigned* p, unsigned v) { return __hip_atomic_fetch_add(p, v, __ATOMIC_RELAXED, __HIP_MEMORY_SCOPE_AGENT); }
__device__ __forceinline__ unsigned xb_xcc_id() { return (unsigned)__builtin_amdgcn_s_getreg((3 << 11) | 20) & 0xFu; }
#define XB_SPIN(cond, bar) do { unsigned _sp = 0; while (cond) { __builtin_amdgcn_s_sleep(1); \
    if ((++_sp & 255u) == 0u) { if (xb_ld(&(bar)[XB_TMO])) break; if (_sp > XB_SPIN_CAP) { atomicAdd(&(bar)[XB_TMO], 1u); break; } } } } while (0)
struct XcdBarrier { unsigned* bar; unsigned x; volatile LAS unsigned* st; };
__device__ __forceinline__ XcdBarrier xcd_barrier_post(unsigned* bar, volatile LAS unsigned* st) {
    XcdBarrier b; b.bar = bar; b.x = xb_xcc_id(); b.st = st;
    if (threadIdx.x == 0) (void)xb_add(&bar[XB_XCNT(b.x)], 1u);
    return b;
}
__device__ __forceinline__ void xcd_barrier_complete(unsigned* bar, unsigned x, unsigned& nloc, unsigned& nx) {
    const unsigned G = gridDim.x * gridDim.y * gridDim.z;
    unsigned sum, cnt, mine, sp = 0u;
    for (;;) {
        sum = 0u; cnt = 0u; mine = 0u;
#pragma unroll
        for (unsigned j = 0; j < 16; ++j) { const unsigned c = xb_ld(&bar[XB_XCNT(j)]); sum += c; cnt += (c > 0u) ? 1u : 0u; mine = (j == x) ? c : mine; }
        if (sum == G) break;
        __builtin_amdgcn_s_sleep(1);
        if ((++sp & 255u) == 0u) { if (xb_ld(&bar[XB_TMO])) break; if (sp > XB_SPIN_CAP) { atomicAdd(&bar[XB_TMO], 1u); break; } }
    }
    nloc = mine > 0u ? mine : 1u; nx = cnt > 0u ? cnt : 1u;
}
__device__ __forceinline__ void xcd_barrier(const XcdBarrier& b) {
    asm volatile("s_waitcnt vmcnt(0)" ::: "memory");
    __syncthreads();
    if (threadIdx.x == 0) {
        unsigned* bar = b.bar;
        __builtin_amdgcn_s_waitcnt(0);
        unsigned nloc = b.st[0], nx = b.st[1];
        if (nloc == 0u) { xcd_barrier_complete(bar, b.x, nloc, nx); b.st[0] = nloc; b.st[1] = nx; }
        const unsigned old = xb_add(&bar[XB_XSUB(b.x)], 1u);
        const unsigned gen = old / nloc;
        if (old + 1u == (gen + 1u) * nloc) {
            __builtin_amdgcn_fence(__ATOMIC_RELEASE, "agent");
            asm volatile("s_waitcnt vmcnt(0)" ::: "memory");
            const unsigned og = xb_add(&bar[XB_TOP], 1u);
            const unsigned tg = og / nx;
            if (og + 1u == (tg + 1u) * nx) xb_add(&bar[XB_TOPGEN], 1u);
            else XB_SPIN(xb_ld(&bar[XB_TOPGEN]) == tg, bar);
            __builtin_amdgcn_fence(__ATOMIC_ACQUIRE, "agent");
            xb_add(&bar[XB_XGEN(b.x)], 1u);
            asm volatile("s_waitcnt vmcnt(0)" ::: "memory");
        } else {
            XB_SPIN(xb_ld(&bar[XB_XGEN(b.x)]) == gen, bar);
            __builtin_amdgcn_fence(__ATOMIC_ACQUIRE, "agent");
            asm volatile("s_waitcnt vmcnt(0)" ::: "memory");
        }
    }
    __syncthreads();
}

__global__ void __launch_bounds__(NT, 2) mk_fwd(Params p) {
    __builtin_assume(__builtin_amdgcn_workitem_id_y() == 0); __builtin_assume(__builtin_amdgcn_workitem_id_z() == 0);
    extern __shared__ __attribute__((aligned(16))) unsigned char lds_raw[];
    cg::grid_group grid = cg::this_grid();
    Frame F; F.lds = (LAS unsigned char*)lds_raw; F.tid = threadIdx.x; F.lane = F.tid & 63; F.wave = __builtin_amdgcn_readfirstlane(F.tid >> 6);
    F.G = gridDim.x; F.bid = blockIdx.x; F.gw = F.bid * NWAVES + F.wave; F.NGW = F.G * NWAVES; F.ws = p.ws;
    unsigned char* ws = p.ws;
    LAS int* tile_e = (LAS int*)(F.lds + LDS_GEMM);
    volatile LAS unsigned* xst = (volatile LAS unsigned*)(F.lds + LDS_GEMM + 4608);
    if (F.tid == 0) { xst[0] = 0u; xst[1] = 0u; }
    __syncthreads();
    XcdBarrier xbar = xcd_barrier_post((unsigned*)(ws + WS_BAR), xst);
#ifndef PROBE_A
#define PROBE_A -1
#define PROBE_B -1
#endif
#ifndef PROBE_BID
#define PROBE_BID 0
#endif
    LAS unsigned long long* stamps = (LAS unsigned long long*)(F.lds + LDS_GEMM + 4096);
#define STAMP(i) do { if (PROBE_A >= 0 && F.bid == PROBE_BID && F.tid == 0) stamps[i] = __builtin_amdgcn_s_memrealtime(); } while (0)
    if (PROBE_A >= 0 && F.bid == PROBE_BID && F.tid == 0) { for (int i = 40; i < 50; ++i) stamps[i] = 0; }
    STAMP(0);
#define IN(k) (p.ph_lo <= (k) && (k) < p.ph_hi)
#define SYNC(k) do { if (IN(k) && IN((k) + 1)) { if ((k) == 0) grid.sync(); else xcd_barrier(xbar); } } while (0)
    if (IN(0)) phase0(F, p);
    SYNC(0); STAMP(1);
    if (IN(1)) {
        expand_tt(F);
        __syncthreads(); STAMP(20);
        pg8::Gemm g{(const bf16_t*)(ws + WS_H), (const bf16_t*)(ws + WS_WIN), 1024, 1024, 1024}; pg8::Sched S = sched_dense(F, MTOK, NIN, 1024, 1024);
        EpiInProj E{(bf16_t*)(ws + WS_Q), (bf16_t*)(ws + WS_MID), (bf16_t*)(ws + WS_UG), (bf16_t*)(ws + WS_GATES), INP(18)};
        pg8::gemm_phase(F.lds, g, S, E);
        { pg8::Gemm g2{(const bf16_t*)(ws + WS_WUPA), (const bf16_t*)(ws + WS_WO), 512, 512, 512}; pg8::Sched S2 = sched_dense(F, 1024, 1024, 512, 512);
          EpiPlain E2{(bf16_t*)(ws + WS_WC), 1024, 0}; pg8::gemm_phase(F.lds, g2, S2, E2); }
    }
    SYNC(1); STAMP(2);
    if (IN(2)) {
        { pg8::Gemm g{(const bf16_t*)(ws + WS_Q), (const bf16_t*)(ws + WS_WQL), 512, 512, 512}; pg8::Sched S = sched_dense(F, MTOK, 1024, 512, 512);
          EpiPlain E{(bf16_t*)(ws + WS_QLAT), 1024, 0}; pg8::gemm_phase(F.lds, g, S, E); }
        STAMP(21);
        { pg8::Gemm g{(const bf16_t*)(ws + WS_UG), (const bf16_t*)(ws + WS_WST), UGP, 1024, 1024}; pg8::Sched S = sched_batch(F, 32, 4, 1, UGP, 1024, (size_t)1024 * UGP * 2, (size_t)256 * 1024 * 2);
          EpiSst E{(float*)(ws + WS_SST)}; pg8::gemm_phase(F.lds, g, S, E); }
        __syncthreads(); STAMP(22);
        phase_cnorm(F, p); STAMP(23);
        phase_topk(F); STAMP(24);
    }
    SYNC(2); STAMP(3);
    if (IN(3)) { phase_scan(F); STAMP(25); phase_attn(F, p); STAMP(26); }
    SYNC(3); STAMP(4);
    if (IN(4)) {
        { pg8::Gemm g{(const bf16_t*)(ws + WS_UG), (const bf16_t*)(ws + WS_TT), UGP, UGP, UGP}; pg8::Sched S = sched_batch(F, 32, 4, 4, UGP, UGP, (size_t)1024 * UGP * 2, (size_t)1024 * UGP * 2);
          EpiS5Out E{(bf16_t*)(ws + WS_Z)}; pg8::gemm_phase(F.lds, g, S, E); }
        STAMP(27);
    }
    SYNC(4); STAMP(5);
    if (IN(5)) {
        { pg8::Gemm g{(const bf16_t*)(ws + WS_Z), (const bf16_t*)(ws + WS_WGLU), 512, 512, 512}; pg8::Sched S = sched_dense(F, MTOK, 1024, 512, 512);
          EpiGlu<0> E{(bf16_t*)(ws + WS_S5OUT), 512}; pg8::gemm_phase(F.lds, g, S, E); }
        STAMP(28);
        { pg8::Gemm g{(const bf16_t*)(ws + WS_QLAT), (const bf16_t*)(ws + WS_WC), 1024, 1024, 1024}; pg8::Sched S = sched_dense(F, MTOK, 1024, 1024, 1024);
          EpiGateMul E{(bf16_t*)(ws + WS_T), (const bf16_t*)(ws + WS_GATES), 0, nullptr}; pg8::gemm_phase(F.lds, g, S, E); }
    }
    SYNC(5); STAMP(6);
    if (IN(6)) {
        pg8::Gemm g{(const bf16_t*)(ws + WS_S5OUT), (const bf16_t*)(ws + WS_WUPB), 512, 512, 512}; pg8::Sched S = sched_dense(F, MTOK, 1024, 512, 512);
        EpiGateMul E{(bf16_t*)(ws + WS_MIXIN), (const bf16_t*)(ws + WS_GATES), 1024, (const bf16_t*)(ws + WS_T)}; pg8::gemm_phase(F.lds, g, S, E);
    }
    SYNC(6); STAMP(7);
    if (IN(7)) {
        pg8::Gemm g{(const bf16_t*)(ws + WS_MIXIN), (const bf16_t*)(ws + WS_WOUT), 1024, 1024, 1024}; pg8::Sched S = sched_dense(F, MTOK, 1024, 1024, 1024);
        EpiResid E{INP(0), p.out}; pg8::gemm_phase(F.lds, g, S, E);
    }
    SYNC(7); STAMP(8);
    if (IN(8)) phase_route(F, p);
    SYNC(8); STAMP(9);
    if (IN(9)) phase_scatter(F);
    SYNC(9); STAMP(10);
    if (IN(10)) {
        const int ntiles = build_tile_table(F, tile_e);
        pg8::Gemm g{(const bf16_t*)(ws + WS_XS), (const bf16_t*)(ws + WS_WGU), 1024, 1024, 1024};
        pg8::Sched S; S.mode = 2; S.nM = ntiles; S.nN = 4; S.nwg = ntiles * 4; S.G = F.G; S.c = F.bid; S.tstepA = (size_t)256 * 1024 * 2; S.tstepB = (size_t)256 * 1024 * 2; S.zstepA = 0; S.zstepB = (size_t)1024 * 1024 * 2; S.tile_e = tile_e;
        EpiGlu<1> E{(bf16_t*)(ws + WS_HB), 512}; pg8::gemm_phase(F.lds, g, S, E);
    }
    SYNC(10); STAMP(11);
    if (IN(11)) {
        const int ntiles = build_tile_table(F, tile_e);
        pg8::Gemm g{(const bf16_t*)(ws + WS_HB), (const bf16_t*)(ws + WS_WD), 512, 512, 512};
        pg8::Sched S; S.mode = 2; S.nM = ntiles; S.nN = 4; S.nwg = ntiles * 4; S.G = F.G; S.c = F.bid; S.tstepA = (size_t)256 * 512 * 2; S.tstepB = (size_t)256 * 512 * 2; S.zstepA = 0; S.zstepB = (size_t)1024 * 512 * 2; S.tile_e = tile_e;
        EpiPlain E{(bf16_t*)(ws + WS_YS), 1024, 0}; pg8::gemm_phase(F.lds, g, S, E);
    }
    SYNC(11); STAMP(12);
    if (IN(12)) phase_final(F, p);
    STAMP(13);
    if (PROBE_A >= 0 && F.bid == PROBE_BID && F.tid == 0) { const unsigned long long dt = 4ull * (stamps[PROBE_B] - stamps[PROBE_A]), t0 = __builtin_amdgcn_s_memrealtime();
        while (__builtin_amdgcn_s_memrealtime() - t0 < dt) __builtin_amdgcn_s_sleep(8); }
#undef IN
#undef SYNC
}

extern "C" void kernel_launch(void* const* d_in, const int* in_sizes, int n_in, void* d_out, int out_size, void* d_ws, size_t ws_size, hipStream_t stream) {
    static int grid_blocks = 0;
    if (!grid_blocks) {
        if (n_in != 29 || out_size != MTOK * DM || ws_size < WS_END) { fprintf(stderr, "kernel_launch: unexpected shapes (n_in %d out %d ws %zu, need ws %zu)\n", n_in, out_size, ws_size, (size_t)WS_END); grid_blocks = -1; return; }
        int dev = 0, cus = 0, per_cu = 0;
        (void)hipGetDevice(&dev);
        (void)hipDeviceGetAttribute(&cus, hipDeviceAttributeMultiprocessorCount, dev);
        (void)hipFuncSetAttribute((const void*)mk_fwd, hipFuncAttributeMaxDynamicSharedMemorySize, LDS_BYTES);
        (void)hipOccupancyMaxActiveBlocksPerMultiprocessor(&per_cu, (const void*)mk_fwd, NT, LDS_BYTES);
        if (per_cu < 1) { fprintf(stderr, "kernel_launch: occupancy query reports %d blocks per CU\n", per_cu); per_cu = 1; }
        grid_blocks = cus;
        fprintf(stderr, "kernel_launch: grid %d (cus %d, per_cu %d)\n", grid_blocks, cus, per_cu);
    }
    if (grid_blocks < 0) return;
    (void)hipMemsetAsync((char*)d_ws + WS_BAR, 0, XCD_BAR_WORDS * sizeof(unsigned), stream);
    Params p{};
    for (int i = 0; i < 29; ++i) p.in[i] = (const float*)d_in[i];
    p.out = (float*)d_out; p.ws = (unsigned char*)d_ws; p.ph_lo = 0; p.ph_hi = 13;
    void* args[] = {&p};
    hipError_t e = hipLaunchCooperativeKernel((const void*)mk_fwd, dim3(grid_blocks), dim3(NT), args, LDS_BYTES, stream);
    if (e != hipSuccess) fprintf(stderr, "cooperative launch failed: %s (grid %d)\n", hipGetErrorString(e), grid_blocks);
}
```
